# Optimizing an MI355X kernel written in HIP

```python
import math
import jax, jax.numpy as jnp
from jax import lax
import numpy as np

D_MODEL = 1024
BATCH = 8
SEQ = 4096
DEPTH = 1

CHUNK = 64
N_META = 16
Q_BLOCK = 128
MIX_WIDTH = D_MODEL
EPS = 1e-6
NEG = -1e30

DA_HEADS = 4
DA_WIDTH = MIX_WIDTH // 2
DA_V_DIM = DA_WIDTH // DA_HEADS
DA_HEAD_DIM = DA_V_DIM // 2
DA_QK = DA_HEADS * 2 * DA_HEAD_DIM

MLA_HEADS = 4
MLA_WIDTH = MIX_WIDTH - DA_WIDTH
MLA_V = MLA_WIDTH // MLA_HEADS
MLA_NOPE = 128
MLA_ROPE = 64
MLA_Q_RANK = D_MODEL // 4
MLA_KV_RANK = D_MODEL // 8
ROPE_THETA = 10000.0

IN_SIZES = (DA_QK, DA_QK, DA_WIDTH, MLA_Q_RANK, MLA_KV_RANK, MLA_ROPE)
IN_WIDTH = sum(IN_SIZES)
IN_SPLITS = tuple(int(s) for s in np.cumsum(IN_SIZES)[:-1])

D_FF = 4 * D_MODEL

kernel_name = "hymba_diffattn_mla_sandwich_block"


def _rms(x, g):
    xf = x.astype(jnp.float32)
    y = xf * lax.rsqrt(jnp.mean(xf * xf, axis=-1, keepdims=True) + EPS)
    return (y * g.astype(jnp.float32)).astype(x.dtype)


def _chunk_ids(pos):
    return jnp.where(pos < N_META, 0, (pos - N_META) // CHUNK + 1)


def _chunk_mask(qpos, kpos):
    return _chunk_ids(kpos)[None, :] <= _chunk_ids(qpos)[:, None]


def _sweep_query_blocks(fn, qs, L):
    n_blk = -(-L // Q_BLOCK)
    Lp = n_blk * Q_BLOCK

    def prep(q):
        b, h, _, d = q.shape
        q = jnp.pad(q, ((0, 0), (0, 0), (0, Lp - L), (0, 0)))
        return jnp.moveaxis(q.reshape(b, h, n_blk, Q_BLOCK, d), 2, 0)

    qpos = jnp.arange(Lp, dtype=jnp.int32).reshape(n_blk, Q_BLOCK)
    out = lax.map(lambda a: fn(a[0], *a[1]), (qpos, tuple(prep(q) for q in qs)))
    nb, b, h, qb, dv = out.shape
    out = jnp.moveaxis(out, 0, 2).reshape(b, h, Lp, dv)
    return out[:, :, :L]


def _rope_tables(L):
    inv_freq = 1.0 / (ROPE_THETA ** (jnp.arange(0, MLA_ROPE, 2, dtype=jnp.float32) / MLA_ROPE))
    ang = jnp.arange(L, dtype=jnp.float32)[:, None] * inv_freq[None, :]
    return jnp.cos(ang), jnp.sin(ang)


def _rope(x, cos, sin):
    half = x.shape[-1] // 2
    x1, x2 = x[..., :half], x[..., half:]
    c = cos.astype(x.dtype)
    s = sin.astype(x.dtype)
    return jnp.concatenate([x1 * c - x2 * s, x2 * c + x1 * s], axis=-1)


def _diff_attention(q, k, v, lq1, lk1, lq2, lk2, g_sub, lambda_init):
    B, L, _ = q.shape
    q = q.reshape(B, L, DA_HEADS, 2, DA_HEAD_DIM).transpose(0, 2, 1, 3, 4)
    k = k.reshape(B, L, DA_HEADS, 2, DA_HEAD_DIM).transpose(0, 2, 1, 3, 4)
    q1, q2 = q[..., 0, :], q[..., 1, :]
    k1, k2 = k[..., 0, :], k[..., 1, :]
    v = v.reshape(B, L, DA_HEADS, DA_V_DIM).transpose(0, 2, 1, 3)

    f32 = jnp.float32
    lam = (jnp.exp(jnp.sum(lq1.astype(f32) * lk1.astype(f32)))
           - jnp.exp(jnp.sum(lq2.astype(f32) * lk2.astype(f32))) + lambda_init)
    slopes = 2.0 ** (-8.0 * jnp.arange(1, DA_HEADS + 1, dtype=f32) / DA_HEADS)
    scale = DA_HEAD_DIM ** -0.5
    kpos = jnp.arange(L, dtype=jnp.int32)

    def blk(qp, q1b, q2b):
        mask = _chunk_mask(qp, kpos)
        dist = jnp.abs(qp[:, None] - kpos[None, :]).astype(f32)
        bias = jnp.where(mask[None], -slopes[:, None, None] * dist[None], NEG)
        s1 = jnp.einsum('bhqd,bhkd->bhqk', q1b, k1).astype(f32) * scale + bias
        s2 = jnp.einsum('bhqd,bhkd->bhqk', q2b, k2).astype(f32) * scale + bias
        a = jax.nn.softmax(s1, axis=-1) - lam * jax.nn.softmax(s2, axis=-1)
        return jnp.einsum('bhqk,bhkv->bhqv', a.astype(v.dtype), v)

    o = _sweep_query_blocks(blk, (q1, q2), L)
    o = _rms(o, g_sub) * (1.0 - lambda_init)
    return o.transpose(0, 2, 1, 3).reshape(B, L, DA_WIDTH)


def _mla(cq, ckv, kr, g_q, w_q_up, g_kv, w_kv_up, cos, sin):
    B, L, _ = cq.shape
    q = (_rms(cq, g_q) @ w_q_up).reshape(B, L, MLA_HEADS, MLA_NOPE + MLA_ROPE)
    q_nope = q[..., :MLA_NOPE]
    q_rope = _rope(q[..., MLA_NOPE:], cos[:, None, :], sin[:, None, :])
    kv = (_rms(ckv, g_kv) @ w_kv_up).reshape(B, L, MLA_HEADS, MLA_NOPE + MLA_V)
    k_nope, v = kv[..., :MLA_NOPE], kv[..., MLA_NOPE:]
    k_rope = _rope(kr, cos, sin)

    q = jnp.concatenate([q_nope, q_rope], axis=-1).transpose(0, 2, 1, 3)
    k = jnp.concatenate(
        [k_nope, jnp.broadcast_to(k_rope[:, :, None, :], (B, L, MLA_HEADS, MLA_ROPE))],
        axis=-1).transpose(0, 2, 1, 3)
    v = v.transpose(0, 2, 1, 3)
    scale = (MLA_NOPE + MLA_ROPE) ** -0.5
    kpos = jnp.arange(L, dtype=jnp.int32)

    def blk(qp, qb):
        bias = jnp.where(_chunk_mask(qp, kpos), 0.0, NEG).astype(jnp.float32)
        s = jnp.einsum('bhqd,bhkd->bhqk', qb, k).astype(jnp.float32) * scale + bias
        p = jax.nn.softmax(s, axis=-1)
        return jnp.einsum('bhqk,bhkv->bhqv', p.astype(v.dtype), v)

    o = _sweep_query_blocks(blk, (q,), L)
    return o.transpose(0, 2, 1, 3).reshape(B, L, MLA_WIDTH)


def setup_inputs(seed: int = 0) -> dict:
    key = jax.random.key(seed)
    ks = jax.random.split(key, 24)
    f32 = jnp.float32

    def nrm(k, shape, scale):
        return jax.random.normal(k, shape, f32) * scale

    def gain(k, shape):
        return 1.0 + 0.02 * jax.random.normal(k, shape, f32)

    return {
        "x": nrm(ks[0], (BATCH, SEQ, D_MODEL), 1.0),
        "meta_tokens": nrm(ks[1], (N_META, D_MODEL), 1.0),
        "g_attn_pre": gain(ks[2], (DEPTH, D_MODEL)),
        "w_in": nrm(ks[3], (DEPTH, D_MODEL, IN_WIDTH), D_MODEL ** -0.5),
        "da_lambda_q1": nrm(ks[4], (DEPTH, DA_HEAD_DIM), 0.1),
        "da_lambda_k1": nrm(ks[5], (DEPTH, DA_HEAD_DIM), 0.1),
        "da_lambda_q2": nrm(ks[6], (DEPTH, DA_HEAD_DIM), 0.1),
        "da_lambda_k2": nrm(ks[7], (DEPTH, DA_HEAD_DIM), 0.1),
        "g_da_sub": gain(ks[8], (DEPTH, DA_V_DIM)),
        "g_mla_q": gain(ks[9], (DEPTH, MLA_Q_RANK)),
        "w_mla_q_up": nrm(ks[10], (DEPTH, MLA_Q_RANK, MLA_HEADS * (MLA_NOPE + MLA_ROPE)), MLA_Q_RANK ** -0.5),
        "g_mla_kv": gain(ks[11], (DEPTH, MLA_KV_RANK)),
        "w_mla_kv_up": nrm(ks[12], (DEPTH, MLA_KV_RANK, MLA_HEADS * (MLA_NOPE + MLA_V)), MLA_KV_RANK ** -0.5),
        "w_o": nrm(ks[13], (DEPTH, MIX_WIDTH, D_MODEL), MIX_WIDTH ** -0.5),
        "g_attn_post": gain(ks[14], (DEPTH, D_MODEL)),
        "g_mlp_pre": gain(ks[15], (DEPTH, D_MODEL)),
        "w_ff1": nrm(ks[16], (DEPTH, D_MODEL, D_FF), D_MODEL ** -0.5),
        "w_ff2": nrm(ks[17], (DEPTH, D_FF, D_MODEL), D_FF ** -0.5),
        "g_mlp_post": gain(ks[18], (DEPTH, D_MODEL)),
    }


def reference(x, meta_tokens, g_attn_pre, w_in, da_lambda_q1, da_lambda_k1, da_lambda_q2,
              da_lambda_k2, g_da_sub, g_mla_q, w_mla_q_up, g_mla_kv, w_mla_kv_up, w_o,
              g_attn_post, g_mlp_pre, w_ff1, w_ff2, g_mlp_post):
    B = x.shape[0]
    meta = jnp.broadcast_to(meta_tokens.astype(x.dtype)[None], (B, N_META, D_MODEL))
    h = jnp.concatenate([meta, x], axis=1)
    L = h.shape[1]
    cos, sin = _rope_tables(L)

    for l in range(DEPTH):
        lambda_init = 0.8 - 0.6 * math.exp(-0.3 * l)
        u = _rms(h, g_attn_pre[l])
        proj = u @ w_in[l]
        q_da, k_da, v_da, cq, ckv, kr = jnp.split(proj, IN_SPLITS, axis=-1)
        y_da = _diff_attention(q_da, k_da, v_da, da_lambda_q1[l], da_lambda_k1[l],
                               da_lambda_q2[l], da_lambda_k2[l], g_da_sub[l], lambda_init)
        y_mla = _mla(cq, ckv, kr, g_mla_q[l], w_mla_q_up[l], g_mla_kv[l], w_mla_kv_up[l], cos, sin)
        mix = jnp.concatenate([y_da, y_mla], axis=-1) @ w_o[l]
        h = h + _rms(mix, g_attn_post[l])
        u = _rms(h, g_mlp_pre[l])
        f = jnp.square(jax.nn.relu(u @ w_ff1[l])) @ w_ff2[l]
        h = h + _rms(f, g_mlp_post[l])

    return h[:, N_META:]
```

```cpp
#ifndef PH
#define PH 0x1ff
#endif
#include <hip/hip_runtime.h>
#include <hip/hip_cooperative_groups.h>
#include <cstdio>
#include <cstdint>
#include <cmath>
namespace cg = cooperative_groups;

#define LAS __attribute__((address_space(3)))
typedef unsigned short bf16_t;
typedef short bf16x8 __attribute__((ext_vector_type(8)));
typedef float f32x4 __attribute__((ext_vector_type(4)));
typedef float f32x2 __attribute__((ext_vector_type(2)));
typedef float f32x16 __attribute__((ext_vector_type(16)));
typedef unsigned u32x4 __attribute__((ext_vector_type(4)));
typedef unsigned u32x2 __attribute__((ext_vector_type(2)));
typedef __bf16 bf16x2_t __attribute__((ext_vector_type(2)));
typedef short v4i16_t __attribute__((ext_vector_type(4)));

constexpr int D_MODEL = 1024, BATCH = 8, SEQ = 4096, N_META = 16, LTOT = SEQ + N_META;
constexpr int MX = BATCH * SEQ;
constexpr int MALL = MX + 256;
constexpr int NPROJ = 2048;
constexpr int PPITCH = 1024;
constexpr int D_FF = 4096;
constexpr float EPS = 1e-6f;
constexpr float LOG2E = 1.4426950408889634f;
constexpr float C2_DA = 0.125f * LOG2E;
constexpr float C2_MLA = 0.07216878364870322f * LOG2E;

constexpr size_t MiB = 1u << 20;
constexpr size_t WS_STAT = 0;
constexpr size_t WS_TAB = 1 * MiB;
constexpr size_t WS_CTL = 3 * MiB;
constexpr size_t WS_WIN = 4 * MiB;
constexpr size_t WS_WQ = 8 * MiB;
constexpr size_t WS_WKV = 9 * MiB;
constexpr size_t WS_WO = 10 * MiB;
constexpr size_t WS_W1 = 12 * MiB;
constexpr size_t WS_W2 = 20 * MiB;
constexpr size_t WS_U = 32 * MiB;
constexpr size_t WS_MIX = 100 * MiB;
constexpr size_t WS_MIXO = 164 * MiB;
constexpr size_t WS_PROJ = 228 * MiB;
constexpr size_t WS_KD = 293 * MiB;
constexpr size_t WS_VD = 326 * MiB;
constexpr size_t WS_QM = 359 * MiB;
constexpr size_t WS_KN = 408 * MiB;
constexpr size_t WS_VM = 441 * MiB;
constexpr size_t WS_KR = 474 * MiB;
constexpr size_t WS_H = 228 * MiB;
constexpr size_t WS_END = 484 * MiB;

namespace pg8 {
constexpr int BM = 256, BK = 64, HALF = 128, HTB = HALF * BK * 2, STAGE_BYTES = 8 * HTB, NXCD = 8, WGM = 8;
__host__ __device__ __forceinline__ int lds_byte(int r, int c) { const int st = (r >> 4) * 2 + (c >> 5), rr = r & 15, cc = c & 31, ob = rr * 64 + cc * 2; return st * 1024 + (ob ^ (((ob >> 9) & 1) << 5)); }
__host__ __device__ __forceinline__ void stage_rc(int b, int& R, int& C) { const int st = b / 1024, sb = b % 1024, swz = sb ^ (((sb >> 9) & 1) << 5); R = (st >> 1) * 16 + swz / 64; C = (st & 1) * 32 + (swz % 64) / 2; }
__host__ __device__ __forceinline__ int perm32(int rho) { const int n = rho >> 4, i = rho & 15; return 8 * (i >> 2) + 4 * n + (i & 3); }
struct Unit { int pm, pn; };
struct Gemm { const bf16_t* A; const bf16_t* Bt; int M, N, K, lda; };
struct StaticOrder {
    int nM, nN, nwg, G, c;
    __host__ __device__ void init(int M, int N, int G_, int c_) { nM = M / BM; nN = N / BM; nwg = nM * nN; G = G_; c = c_; }
    __host__ __device__ bool next(int i, Unit& u) const {
        const long L = (long)i * G + c; if (L >= nwg) return false;
        int wgid = (int)L; { const int q = nwg / NXCD, r = nwg % NXCD, xcd = wgid % NXCD, off = wgid / NXCD; wgid = (xcd < r ? xcd * (q + 1) : r * (q + 1) + (xcd - r) * q) + off; }
        const int nig = WGM * nN, gid = wgid / nig, fm = gid * WGM, gsz = (nM - fm) < WGM ? (nM - fm) : WGM;
        u.pm = fm + ((wgid % nig) % gsz); u.pn = (wgid % nig) / gsz; return true;
    }
    __device__ __forceinline__ void a_ready(const Unit&) const {}
    __device__ __forceinline__ void done(const Unit&) const {}
};
__device__ __forceinline__ unsigned cvt_pk_bf16(float lo, float hi) { f32x2 v = {lo, hi}; bf16x2_t b = __builtin_convertvector(v, bf16x2_t); return __builtin_bit_cast(unsigned, b); }
__device__ __forceinline__ u32x4 pack8(const f32x4& v0, const f32x4& v1) { u32x4 w; w.x = cvt_pk_bf16(v0[0], v0[1]); w.y = cvt_pk_bf16(v0[2], v0[3]); w.z = cvt_pk_bf16(v1[0], v1[1]); w.w = cvt_pk_bf16(v1[2], v1[3]); return w; }
__device__ __forceinline__ float ssq8(const f32x4& a, const f32x4& b) { return (a[0] * a[0] + a[1] * a[1]) + (a[2] * a[2] + a[3] * a[3]) + (b[0] * b[0] + b[1] * b[1]) + (b[2] * b[2] + b[3] * b[3]); }
__device__ __forceinline__ void rope8(f32x4& v0, f32x4& v1, const float* tab, int pos, int i0) {
    const f32x4 t0 = *(const f32x4*)(tab + ((size_t)pos * 32 + i0) * 2), t1 = *(const f32x4*)(tab + ((size_t)pos * 32 + i0 + 2) * 2);
    f32x4 a, b;
    a[0] = v0[0] * t0[0] - v0[1] * t0[1]; a[1] = v0[1] * t0[0] + v0[0] * t0[1];
    a[2] = v0[2] * t0[2] - v0[3] * t0[3]; a[3] = v0[3] * t0[2] + v0[2] * t0[3];
    b[0] = v1[0] * t1[0] - v1[1] * t1[1]; b[1] = v1[1] * t1[0] + v1[0] * t1[1];
    b[2] = v1[2] * t1[2] - v1[3] * t1[3]; b[3] = v1[3] * t1[2] + v1[2] * t1[3];
    v0 = a; v1 = b;
}

struct EpiIn {
    static constexpr bool PERM = true, AFTER_DRAIN = false;
    bf16_t* PROJ; bf16_t* KD; bf16_t* VD; bf16_t* KR; float* RQ; float* RKV; const float* tab;
    __device__ __forceinline__ void operator()(const f32x4 (&acc)[2][2][4][2], const Unit& u, int wr, int wc, int fr, int fq) const {
        const int row0 = u.pm * BM + wr * 64 + fr, cw = wc * 32 + 8 * fq, pn = u.pn;
        bf16_t* base0; bf16_t* base1; int pitch0, pitch1;
        if (pn < 2) { base0 = PROJ + pn * BM; base1 = base0 + HALF; pitch0 = pitch1 = PPITCH; }
        else if (pn < 6) { base0 = (pn < 4 ? KD : VD) + (size_t)((pn & 1) * 2) * MALL * 128; base1 = base0 + (size_t)MALL * 128; pitch0 = pitch1 = 128; }
        else if (pn == 6) { base0 = PROJ + 512; base1 = base0 + HALF; pitch0 = pitch1 = PPITCH; }
        else { base0 = PROJ + 768; pitch0 = PPITCH; base1 = KR; pitch1 = 64; }
        const bool stat = pn >= 6, kr = pn == 7;
#pragma unroll
        for (int ai = 0; ai < 2; ++ai)
#pragma unroll
            for (int m = 0; m < 4; ++m) {
                const int row = row0 + ai * HALF + m * 16;
                { const f32x4 v0 = acc[ai][0][m][0], v1 = acc[ai][0][m][1]; *(u32x4*)(base0 + (size_t)row * pitch0 + cw) = pack8(v0, v1);
                  f32x4 w0 = acc[ai][1][m][0], w1 = acc[ai][1][m][1];
                  if (kr) { if (wc < 2) { const int pos = row < MX ? N_META + (row & (SEQ - 1)) : ((row - MX) < N_META ? (row - MX) : 0);
                                rope8(w0, w1, tab, pos, 16 * wc + 4 * fq); *(u32x4*)(base1 + (size_t)row * pitch1 + cw) = pack8(w0, w1); } }
                  else *(u32x4*)(base1 + (size_t)row * pitch1 + cw) = pack8(w0, w1);
                  if (stat) { float ss = ssq8(v0, v1); if (!kr) ss += ssq8(w0, w1);
                      ss += __shfl_xor(ss, 16); ss += __shfl_xor(ss, 32);
                      if (fq == 0) __hip_atomic_fetch_add((kr ? RKV : RQ) + row, ss, __ATOMIC_RELAXED, __HIP_MEMORY_SCOPE_AGENT); } }
                asm volatile("" ::: "memory");
            }
    }
};
struct EpiQ {
    static constexpr bool PERM = true, AFTER_DRAIN = false;
    bf16_t* QM; const float* RQ; const float* tab;
    __device__ __forceinline__ void operator()(const f32x4 (&acc)[2][2][4][2], const Unit& u, int wr, int wc, int fr, int fq) const {
        const int row0 = u.pm * BM + wr * 64 + fr, colt = u.pn * BM + wc * 32 + 8 * fq;
        const int blk0 = (8 * u.pn + wc) % 6, blk1 = (8 * u.pn + 4 + wc) % 6;
#pragma unroll
        for (int ai = 0; ai < 2; ++ai)
#pragma unroll
            for (int m = 0; m < 4; ++m) {
                const int row = row0 + ai * HALF + m * 16; const float sc = rsqrtf(RQ[row] * (1.0f / 256.0f) + EPS) * C2_MLA; const int pos = N_META + (row & (SEQ - 1));
                { f32x4 v0 = acc[ai][0][m][0] * sc, v1 = acc[ai][0][m][1] * sc;
                  if (blk0 >= 4) rope8(v0, v1, tab, pos, (blk0 - 4) * 16 + 4 * fq);
                  *(u32x4*)(QM + (size_t)row * 768 + colt) = pack8(v0, v1); }
                { f32x4 v0 = acc[ai][1][m][0] * sc, v1 = acc[ai][1][m][1] * sc;
                  if (blk1 >= 4) rope8(v0, v1, tab, pos, (blk1 - 4) * 16 + 4 * fq);
                  *(u32x4*)(QM + (size_t)row * 768 + colt + HALF) = pack8(v0, v1); }
                asm volatile("" ::: "memory");
            }
    }
};
struct EpiKV {
    static constexpr bool PERM = true, AFTER_DRAIN = false;
    bf16_t* KN; bf16_t* VM; const float* RKV;
    __device__ __forceinline__ void operator()(const f32x4 (&acc)[2][2][4][2], const Unit& u, int wr, int wc, int fr, int fq) const {
        const int row0 = u.pm * BM + wr * 64 + fr, c0 = wc * 32 + 8 * fq;
#pragma unroll
        for (int ai = 0; ai < 2; ++ai)
#pragma unroll
            for (int m = 0; m < 4; ++m) {
                const int row = row0 + ai * HALF + m * 16; const float sc = rsqrtf(RKV[row] * (1.0f / 128.0f) + EPS);
                *(u32x4*)(KN + ((size_t)u.pn * MALL + row) * 128 + c0) = pack8(acc[ai][0][m][0] * sc, acc[ai][0][m][1] * sc);
                *(u32x4*)(VM + ((size_t)u.pn * MALL + row) * 128 + c0) = pack8(acc[ai][1][m][0] * sc, acc[ai][1][m][1] * sc);
                asm volatile("" ::: "memory");
            }
    }
};
struct EpiSS {
    static constexpr bool PERM = true, AFTER_DRAIN = false;
    bf16_t* O; int ldc; float* SS;
    __device__ __forceinline__ void operator()(const f32x4 (&acc)[2][2][4][2], const Unit& u, int wr, int wc, int fr, int fq) const {
        const int row0 = u.pm * BM + wr * 64 + fr, colt = u.pn * BM + wc * 32 + 8 * fq;
#pragma unroll
        for (int ai = 0; ai < 2; ++ai)
#pragma unroll
            for (int m = 0; m < 4; ++m) {
                const int row = row0 + ai * HALF + m * 16; float ss = 0.f;
#pragma unroll
                for (int bj = 0; bj < 2; ++bj) { const f32x4 v0 = acc[ai][bj][m][0], v1 = acc[ai][bj][m][1];
                    *(u32x4*)(O + (size_t)row * ldc + colt + bj * HALF) = pack8(v0, v1); ss += ssq8(v0, v1); }
                ss += __shfl_xor(ss, 16); ss += __shfl_xor(ss, 32);
                if (fq == 0) __hip_atomic_fetch_add(SS + row, ss, __ATOMIC_RELAXED, __HIP_MEMORY_SCOPE_AGENT);
            }
    }
};
struct EpiRelu2 {
    static constexpr bool PERM = true, AFTER_DRAIN = false;
    bf16_t* O; int ldc;
    __device__ __forceinline__ void operator()(const f32x4 (&acc)[2][2][4][2], const Unit& u, int wr, int wc, int fr, int fq) const {
        const int row0 = u.pm * BM + wr * 64 + fr, colt = u.pn * BM + wc * 32 + 8 * fq;
#pragma unroll
        for (int ai = 0; ai < 2; ++ai)
#pragma unroll
            for (int m = 0; m < 4; ++m) {
                const int row = row0 + ai * HALF + m * 16;
#pragma unroll
                for (int bj = 0; bj < 2; ++bj) { f32x4 v0 = acc[ai][bj][m][0], v1 = acc[ai][bj][m][1];
#pragma unroll
                    for (int e = 0; e < 4; ++e) { const float a = fmaxf(v0[e], 0.f), b = fmaxf(v1[e], 0.f); v0[e] = a * a; v1[e] = b * b; }
                    *(u32x4*)(O + (size_t)row * ldc + colt + bj * HALF) = pack8(v0, v1); }
            }
    }
};

template <class Epi, class Sched, bool ALIGN_EPI = false, bool SP2 = false>
__device__ __forceinline__ void gemm_phase(LAS unsigned char* lds, const Gemm g, const Sched& S, const Epi& E) {
    int tid_ = threadIdx.x; asm volatile("" : "+v"(tid_));
    const int tid = tid_, wid = __builtin_amdgcn_readfirstlane(tid >> 6), lane = tid & 63, wr = wid >> 2, wc = wid & 3, fr = lane & 15, fq = lane >> 4;
    int K_ = g.K; asm volatile("" : "+s"(K_));
    const int K = K_, nt = K / BK, lda = g.lda;
    unsigned voffA[2], voffB[2];
#pragma unroll
    for (int i = 0; i < 2; ++i) { int R, C; stage_rc(tid * 16 + i * 8192, R, C); const int Rb = Epi::PERM ? ((R & ~31) + perm32(R & 31)) : R;
        voffA[i] = (unsigned)(R * lda + C) * 2u; voffB[i] = (unsigned)(Rb * K + C) * 2u; }
    const size_t kstep = (size_t)(BK * 2);
    const size_t hstepA = (size_t)HALF * lda * 2, hstepB = (size_t)HALF * K * 2;
    const size_t tstepA = 2 * hstepA, tstepB = 2 * hstepB;
    const unsigned ldsw = (unsigned)wid * 1024u;
    const int aoff = lds_byte(wr * 64 + fr, fq * 8), boff = lds_byte(wc * 32 + fr, fq * 8);
#define PG8_SA(b, h) (((b) * 2 + (h)) * HTB)
#define PG8_SB(b, h) ((4 + (b) * 2 + (h)) * HTB)
#define PG8_STAGE(bufoff, gbase, voff) do { _Pragma("unroll") for (int _i = 0; _i < 2; ++_i) \
        __builtin_amdgcn_global_load_lds((const unsigned*)((const char*)(gbase) + (voff)[_i]), (LAS unsigned*)(lds + (bufoff) + ldsw + _i * 8192), 16, 0, 0); } while (0)
#define PG8_LDA(dst, b, h) do { _Pragma("unroll") for (int m = 0; m < 4; ++m) _Pragma("unroll") for (int k = 0; k < 2; ++k) dst[m][k] = *(const LAS bf16x8*)(lds + PG8_SA(b, h) + aoff + m * 2048 + k * 1024); } while (0)
#define PG8_LDB(dst, b, h) do { _Pragma("unroll") for (int n = 0; n < 2; ++n) _Pragma("unroll") for (int k = 0; k < 2; ++k) dst[n][k] = *(const LAS bf16x8*)(lds + PG8_SB(b, h) + boff + n * 2048 + k * 1024); } while (0)
#define PG8_MMA(ai, bj, At, Bt) do { __builtin_amdgcn_s_setprio(1); _Pragma("unroll") for (int m = 0; m < 4; ++m) _Pragma("unroll") for (int n = 0; n < 2; ++n) _Pragma("unroll") for (int k = 0; k < 2; ++k) \
        acc[ai][bj][m][n] = __builtin_amdgcn_mfma_f32_16x16x32_bf16(Bt[n][k], At[m][k], acc[ai][bj][m][n], 0, 0, 0); __builtin_amdgcn_s_setprio(0); } while (0)
#define PG8_WAIT_V(n) asm volatile("s_waitcnt vmcnt(" #n ")" ::: "memory")
#define PG8_WAIT_L(n) asm volatile("s_waitcnt lgkmcnt(" #n ")" ::: "memory")
#define PG8_BAR __builtin_amdgcn_s_barrier()
#define PG8_SCHED __builtin_amdgcn_sched_barrier(0)
    Unit cur, nxt; int ui = 0;
    if (!S.next(0, cur)) return;
    f32x4 acc[2][2][4][2];
#pragma unroll
    for (int a = 0; a < 2; ++a)
#pragma unroll
        for (int b = 0; b < 2; ++b)
#pragma unroll
            for (int m = 0; m < 4; ++m)
#pragma unroll
                for (int n = 0; n < 2; ++n) acc[a][b][m][n] = (f32x4){0.f, 0.f, 0.f, 0.f};
    bf16x8 At[4][2], B0[2][2], B1[2][2];
    const char* cA = (const char*)g.A + (size_t)cur.pm * tstepA; const char* cB = (const char*)g.Bt + (size_t)cur.pn * tstepB;
    S.a_ready(cur);
    if constexpr (SP2) {
        PG8_STAGE(PG8_SB(0, 0), cB, voffB); PG8_STAGE(PG8_SB(0, 1), cB + hstepB, voffB); PG8_STAGE(PG8_SA(0, 0), cA, voffA); PG8_STAGE(PG8_SA(0, 1), cA + hstepA, voffA);
        if (wr == 1) PG8_BAR;
        PG8_WAIT_V(2); PG8_BAR;
        PG8_STAGE(PG8_SB(1, 0), cB + kstep, voffB); PG8_STAGE(PG8_SA(1, 0), cA + kstep, voffA); PG8_STAGE(PG8_SB(1, 1), cB + hstepB + kstep, voffB);
        PG8_WAIT_V(6); PG8_BAR;
    } else {
        PG8_STAGE(PG8_SB(0, 0), cB, voffB); PG8_STAGE(PG8_SA(0, 0), cA, voffA); PG8_STAGE(PG8_SB(0, 1), cB + hstepB, voffB); PG8_STAGE(PG8_SA(0, 1), cA + hstepA, voffA);
        if (wr == 1) PG8_BAR;
        PG8_WAIT_V(4); PG8_BAR;
        PG8_STAGE(PG8_SB(1, 0), cB + kstep, voffB); PG8_STAGE(PG8_SA(1, 0), cA + kstep, voffA); PG8_STAGE(PG8_SB(1, 1), cB + hstepB + kstep, voffB);
        PG8_WAIT_V(6); PG8_BAR;
    }
    for (;;) {
        const bool has_next = S.next(ui + 1, nxt);
        const char* nA = has_next ? (const char*)g.A + (size_t)nxt.pm * tstepA : cA; const char* nB = has_next ? (const char*)g.Bt + (size_t)nxt.pn * tstepB : cB;
#pragma clang loop unroll(disable)
        for (int t = 0; t < nt; t += 2) {
            const bool last = (t == nt - 2);
            const char* a1 = cA + (size_t)(t + 1) * kstep;
            const char* a2 = last ? nA : cA + (size_t)(t + 2) * kstep; const char* b2 = last ? nB : cB + (size_t)(t + 2) * kstep;
            const char* a3 = a2 + kstep; const char* b3 = b2 + kstep;
            if (last && has_next) S.a_ready(nxt);
            if constexpr (SP2) {
            PG8_LDB(B0, 0, 0); PG8_LDB(B1, 0, 1); PG8_SCHED; PG8_LDA(At, 0, 0); PG8_STAGE(PG8_SA(1, 1), a1 + hstepA, voffA);
            PG8_WAIT_V(8); PG8_WAIT_L(0); PG8_BAR; PG8_MMA(0, 0, At, B0); PG8_MMA(0, 1, At, B1); PG8_BAR; PG8_SCHED;
            PG8_LDA(At, 0, 1); PG8_STAGE(PG8_SB(0, 0), b2, voffB); PG8_STAGE(PG8_SB(0, 1), b2 + hstepB, voffB); PG8_STAGE(PG8_SA(0, 0), a2, voffA);
            PG8_WAIT_V(8); PG8_WAIT_L(0); PG8_BAR; PG8_MMA(1, 0, At, B0); PG8_MMA(1, 1, At, B1); PG8_BAR; PG8_SCHED;
            PG8_LDB(B0, 1, 0); PG8_LDB(B1, 1, 1); PG8_SCHED; PG8_LDA(At, 1, 0); PG8_STAGE(PG8_SA(0, 1), a2 + hstepA, voffA);
            PG8_WAIT_V(8); PG8_WAIT_L(0); PG8_BAR; PG8_MMA(0, 0, At, B0); PG8_MMA(0, 1, At, B1); PG8_BAR; PG8_SCHED;
            PG8_LDA(At, 1, 1); PG8_STAGE(PG8_SB(1, 0), b3, voffB); PG8_STAGE(PG8_SB(1, 1), b3 + hstepB, voffB); PG8_STAGE(PG8_SA(1, 0), a3, voffA);
            PG8_WAIT_V(8); PG8_WAIT_L(0); PG8_BAR; PG8_MMA(1, 0, At, B0); PG8_MMA(1, 1, At, B1); PG8_BAR; PG8_SCHED;
            } else {
            PG8_LDB(B0, 0, 0); PG8_SCHED; PG8_LDA(At, 0, 0); PG8_STAGE(PG8_SA(1, 1), a1 + hstepA, voffA);
            PG8_WAIT_L(8); PG8_BAR; PG8_WAIT_L(0); PG8_MMA(0, 0, At, B0); PG8_BAR; PG8_SCHED;
            PG8_LDB(B1, 0, 1); PG8_STAGE(PG8_SB(0, 0), b2, voffB);
            PG8_BAR; PG8_WAIT_L(0); PG8_MMA(0, 1, At, B1); PG8_BAR;
            PG8_LDA(At, 0, 1); PG8_STAGE(PG8_SA(0, 0), a2, voffA);
            PG8_BAR; PG8_WAIT_L(0); PG8_MMA(1, 0, At, B0); PG8_BAR; PG8_SCHED;
            PG8_STAGE(PG8_SB(0, 1), b2 + hstepB, voffB);
            PG8_WAIT_V(6); PG8_BAR; PG8_MMA(1, 1, At, B1); PG8_BAR;
            PG8_LDB(B0, 1, 0); PG8_SCHED; PG8_LDA(At, 1, 0); PG8_STAGE(PG8_SA(0, 1), a2 + hstepA, voffA);
            PG8_WAIT_L(8); PG8_BAR; PG8_WAIT_L(0); PG8_MMA(0, 0, At, B0); PG8_BAR; PG8_SCHED;
            PG8_LDB(B1, 1, 1); PG8_STAGE(PG8_SB(1, 0), b3, voffB);
            PG8_BAR; PG8_WAIT_L(0); PG8_MMA(0, 1, At, B1); PG8_BAR;
            PG8_LDA(At, 1, 1); PG8_STAGE(PG8_SA(1, 0), a3, voffA);
            PG8_BAR; PG8_WAIT_L(0); PG8_MMA(1, 0, At, B0); PG8_BAR; PG8_SCHED;
            PG8_STAGE(PG8_SB(1, 1), b3 + hstepB, voffB);
            PG8_WAIT_V(6); PG8_BAR; PG8_MMA(1, 1, At, B1); PG8_BAR;
            }
        }
        if constexpr (ALIGN_EPI) { if (wr == 0) PG8_BAR; }
        if constexpr (!Epi::AFTER_DRAIN) { E(acc, cur, wr, wc, fr, fq); S.done(cur); }
        if (!has_next) break;
#pragma unroll
        for (int a = 0; a < 2; ++a)
#pragma unroll
            for (int b = 0; b < 2; ++b)
#pragma unroll
                for (int m = 0; m < 4; ++m)
#pragma unroll
                    for (int n = 0; n < 2; ++n) acc[a][b][m][n] = (f32x4){0.f, 0.f, 0.f, 0.f};
        cur = nxt; cA = nA; cB = nB; ++ui;
        if constexpr (ALIGN_EPI) { if (wr == 1) PG8_BAR; }
    }
    PG8_WAIT_V(0);
    if constexpr (!ALIGN_EPI) { if (wr == 0) PG8_BAR; }
    PG8_BAR;
#undef PG8_SA
#undef PG8_SB
#undef PG8_STAGE
#undef PG8_LDA
#undef PG8_LDB
#undef PG8_MMA
#undef PG8_WAIT_V
#undef PG8_WAIT_L
#undef PG8_BAR
#undef PG8_SCHED
}
}

namespace att {
constexpr int VOFF = 26624, BUFB = 43008, NPIECE = 42;
constexpr int KP_DA = 144, KCOMP_DA = 64 * KP_DA;
constexpr int KNP = 272, KR_OFF = 64 * KNP, KRP = 144;
struct Tensors { const bf16_t* PROJ; const bf16_t* KD; const bf16_t* VD; const bf16_t* QM; const bf16_t* KN; const bf16_t* VM; const bf16_t* KR; bf16_t* MIX; const float* gsub; const unsigned* kmax; };
__device__ __forceinline__ float swap_max(float v) { auto rr = __builtin_amdgcn_permlane32_swap(__float_as_uint(v), __float_as_uint(v), false, false); return fmaxf(__uint_as_float(rr[0]), __uint_as_float(rr[1])); }
__device__ __forceinline__ float swap_sum(float v) { auto rr = __builtin_amdgcn_permlane32_swap(__float_as_uint(v), __float_as_uint(v), false, false); return __uint_as_float(rr[0]) + __uint_as_float(rr[1]); }
__device__ __forceinline__ unsigned off_b(unsigned row, unsigned ch) { return 256u * row + 16u * (ch ^ (((row & 3) << 2) | ((row >> 2) & 3))); }
__device__ __forceinline__ unsigned tr_read_addr(unsigned lane, unsigned c, unsigned ks, unsigned t) {
    const unsigned h = lane >> 5, blk = (lane >> 4) & 1, q = (lane & 15) >> 2, p = lane & 3;
    return off_b(16 * ks + 8 * h + 4 * t + q, 4 * c + 2 * blk + (p >> 1)) + 8 * (p & 1);
}
__device__ __forceinline__ bf16x8 pack_p(const f32x16& p, int o) {
    u32x4 w; w.x = pg8::cvt_pk_bf16(p[o + 0], p[o + 1]); w.y = pg8::cvt_pk_bf16(p[o + 2], p[o + 3]); w.z = pg8::cvt_pk_bf16(p[o + 4], p[o + 5]); w.w = pg8::cvt_pk_bf16(p[o + 6], p[o + 7]);
    return __builtin_bit_cast(bf16x8, w);
}

__device__ __forceinline__ void glds16(const void* gsrc, unsigned lds_dst) { unsigned keep;
    asm volatile("s_mov_b32 %0, m0\n\ts_mov_b32 m0, %2\n\ts_nop 0\n\tglobal_load_lds_dwordx4 %1, off\n\ts_mov_b32 m0, %0" : "=&s"(keep) : "v"(gsrc), "s"(lds_dst) : "memory"); }
#define ATT_WAITBAR(N) asm volatile("s_waitcnt vmcnt(" #N ") lgkmcnt(0)\n\ts_barrier" ::: "memory")
__device__ __forceinline__ float mx3(float a, float b, float c) { return __builtin_fmaxf(__builtin_fmaxf(a, b), c); }
template <bool DA>
__device__ __forceinline__ void attn_unit(LAS unsigned char* lds, const Tensors& T, int b, int h, int u, float lam) {
    int tid_ = threadIdx.x; asm volatile("" : "+v"(tid_));
    const int tid = tid_, lane = tid & 63, q32 = lane & 31, hi = lane >> 5;
    const int wid = __builtin_amdgcn_readfirstlane(tid >> 6);
    const int comp = DA ? (wid >> 2) : 0, wq = DA ? (wid & 3) : wid;
    unsigned voff[6];
#pragma unroll
    for (int i = 0; i < 6; ++i) {
        const unsigned pi = wid + 8 * i, o = pi * 1024 + lane * 16; unsigned v = 0;
        if (o < (unsigned)VOFF) {
            if (DA) { const unsigned cp = o / KCOMP_DA, rem = o - cp * KCOMP_DA, key = rem / KP_DA; unsigned cc = (rem - key * KP_DA) >> 4; if (cc == 8) cc = 0; v = (key & 63) * 256 + (cp & 1) * 128 + cc * 16; }
            else if (o < (unsigned)KR_OFF) { const unsigned key = o / KNP; unsigned cc = (o - key * KNP) >> 4; if (cc == 16) cc = 0; v = key * 256 + cc * 16; }
            else { const unsigned o2 = o - KR_OFF, key = o2 / KRP; unsigned cc = (o2 - key * KRP) >> 4; if (cc == 8) cc = 0; v = (key & 63) * 128 + cc * 16; }
        } else {
            const unsigned ov = o - VOFF, img = (ov >> 13) & 1, slot = (ov & 8191) >> 4, rho = slot >> 4, chp = slot & 15;
            const unsigned ch = chp ^ (((rho & 3) << 2) | ((rho >> 2) & 3)), kk = (rho & ~12u) | ((rho & 4) << 1) | ((rho & 8) >> 1), key = 32 * img + kk;
            v = key * 256 + ch * 16;
        }
        voff[i] = v;
    }
    const unsigned lds0 = (unsigned)(size_t)lds;
    const int npiece = DA ? (wid < 2 ? 5 : 4) : (wid < 2 ? 6 : 5);
    constexpr int QPU = DA ? 128 : 256, CPU = QPU / 64;
    const int NT = CPU * u + CPU + 1;
    const int tmax = CPU * u + (wq >> 1) + 1;
    auto issue = [&](int tt, int bufoff) {
        const size_t row0 = (tt == 0) ? (size_t)MX : (size_t)b * SEQ + (size_t)(tt - 1) * 64;
        const char *pK, *pK2, *pV;
        const size_t hrow = ((size_t)h * MALL + row0) * 256;
        if (DA) { pK = (const char*)T.KD + hrow; pK2 = pK; pV = (const char*)T.VD + hrow; }
        else { pK = (const char*)T.KN + hrow; pK2 = (const char*)T.KR + row0 * 128; pV = (const char*)T.VM + hrow; }
#pragma unroll
        for (int i = 0; i < 6; ++i) {
            const int pi = wid + 8 * i;
            if (pi >= NPIECE) continue;
            if (DA && pi >= 18 && pi < 26) continue;
            const char* base = (pi >= 26) ? pV : ((!DA && pi >= 17) ? pK2 : pK);
            glds16(base + voff[i], (unsigned)__builtin_amdgcn_readfirstlane((int)(lds0 + bufoff + pi * 1024)));
        }
    };
    issue(NT - 1, 0); issue(NT - 2, BUFB);
    const int qx = u * QPU + wq * 32 + q32;
    const size_t qrow = (size_t)b * SEQ + qx;
    constexpr int NQF = DA ? 4 : 12;
    bf16x8 qf[NQF];
    if (DA) { const bf16_t* qp = T.PROJ + qrow * PPITCH + 128 * h + 64 * comp + 8 * hi;
#pragma unroll
        for (int s = 0; s < 4; ++s) qf[s] = *(const bf16x8*)(qp + 16 * s); }
    else { const bf16_t* qp = T.QM + qrow * 768 + 192 * h + 8 * hi;
#pragma unroll
        for (int s = 0; s < 12; ++s) qf[s] = *(const bf16x8*)(qp + 16 * s); }
#pragma unroll
    for (int s = 0; s < NQF; ++s) asm volatile("" : "+v"(qf[s]));
    float qbound = 0.f;
    LAS unsigned* vote = (LAS unsigned*)(lds + 131072) + 8;
    if (DA) {
        float ss = 0.f;
#pragma unroll
        for (int s = 0; s < 4; ++s)
#pragma unroll
            for (int e = 0; e < 8; ++e) { const float v = __uint_as_float(((unsigned)(unsigned short)qf[s][e]) << 16); ss += v * v; }
        ss = swap_sum(ss);
        const float km = __uint_as_float(__hip_atomic_load(T.kmax + 2 * h + comp, __ATOMIC_RELAXED, __HIP_MEMORY_SCOPE_AGENT));
        qbound = sqrtf(ss * km) * 1.01f;
        if (tid < 3) vote[tid] = 0u;
    }
    bool wdone = false; int vi = 0;
    f32x16 O[4]; float mrun = -1e30f, lrun = 0.f;
#pragma unroll
    for (int cc = 0; cc < 4; ++cc)
#pragma unroll
        for (int r = 0; r < 16; ++r) O[cc][r] = 0.f;
    const float slope2 = DA ? exp2f(-2.0f * (float)(h + 1)) * LOG2E : 0.f;
    const float H64 = 64.0f * slope2, H32 = 32.0f * slope2;
    f32x16 cvec;
#pragma unroll
    for (int r = 0; r < 16; ++r) cvec[r] = DA ? slope2 * (float)((r & 3) + 8 * (r >> 2) + 4 * hi) : 0.f;
    unsigned vad[4][2];
#pragma unroll
    for (int cc = 0; cc < 4; ++cc)
#pragma unroll
        for (int t = 0; t < 2; ++t) vad[cc][t] = tr_read_addr(lane, cc, 0, t);
    if (npiece == 6) ATT_WAITBAR(6); else if (npiece == 5) ATT_WAITBAR(5); else ATT_WAITBAR(4);

    int bo0 = 0, bo1 = BUFB, bo2 = 2 * BUFB;
    for (int tt = NT - 1; tt >= 0; --tt) {
        if (tt >= 2) issue(tt - 2, bo2);
        if (tt <= tmax) {
            LAS unsigned char* kb = lds + bo0;
            LAS unsigned char* vb = kb + VOFF;
            f32x16 p0, p1;
#define ATT_VFRAG(dst, cc_, kap_) do { const v4i16_t lo_ = __builtin_amdgcn_ds_read_tr16_b64_v4i16((LAS v4i16_t*)(vb + vad[cc_][0] + ((kap_) & 1) * 4096 + ((kap_) >> 1) * 8192)); \
                const v4i16_t hh_ = __builtin_amdgcn_ds_read_tr16_b64_v4i16((LAS v4i16_t*)(vb + vad[cc_][1] + ((kap_) & 1) * 4096 + ((kap_) >> 1) * 8192)); \
                dst = (bf16x8){lo_[0], lo_[1], lo_[2], lo_[3], hh_[0], hh_[1], hh_[2], hh_[3]}; } while (0)
#define ATT_SB() __builtin_amdgcn_sched_barrier(0)
            bf16x8 va[4], vbf[4];
            if (DA) {
                mrun += H64;
                LAS unsigned char* kp = kb + comp * KCOMP_DA + q32 * KP_DA + hi * 16;
                bf16x8 kf[8];
#pragma unroll
                for (int s = 0; s < 4; ++s) { kf[2 * s] = *(const LAS bf16x8*)(kp + 32 * s); kf[2 * s + 1] = *(const LAS bf16x8*)(kp + 32 * KP_DA + 32 * s); }
                ATT_SB();
                p0 = __builtin_amdgcn_mfma_f32_32x32x16_bf16(kf[0], qf[0], cvec, 0, 0, 0); p1 = __builtin_amdgcn_mfma_f32_32x32x16_bf16(kf[1], qf[0], cvec, 0, 0, 0);
#pragma unroll
                for (int s = 1; s < 4; ++s) { p0 = __builtin_amdgcn_mfma_f32_32x32x16_bf16(kf[2 * s], qf[s], p0, 0, 0, 0); p1 = __builtin_amdgcn_mfma_f32_32x32x16_bf16(kf[2 * s + 1], qf[s], p1, 0, 0, 0); }
                ATT_SB();
            } else {
                const f32x16 z16 = {0.f, 0.f, 0.f, 0.f, 0.f, 0.f, 0.f, 0.f, 0.f, 0.f, 0.f, 0.f, 0.f, 0.f, 0.f, 0.f};
                LAS unsigned char* kp = kb + q32 * KNP + hi * 16;
                LAS unsigned char* kp2 = kb + KR_OFF + q32 * KRP + hi * 16;
                bf16x8 kA[4], kB[4];
#define ATT_KADDR(s_) ((s_) < 8 ? kp + 32 * (s_) : kp2 + 32 * ((s_) - 8))
#define ATT_KLOAD(dst, j_) do { dst[0] = *(const LAS bf16x8*)(ATT_KADDR(2 * (j_))); dst[1] = *(const LAS bf16x8*)(ATT_KADDR(2 * (j_)) + ((j_) < 4 ? 32 * KNP : 32 * KRP)); \
                dst[2] = *(const LAS bf16x8*)(ATT_KADDR(2 * (j_) + 1)); dst[3] = *(const LAS bf16x8*)(ATT_KADDR(2 * (j_) + 1) + ((j_) < 4 ? 32 * KNP : 32 * KRP)); } while (0)
#define ATT_KMM(src, j_) do { p0 = __builtin_amdgcn_mfma_f32_32x32x16_bf16(src[0], qf[2 * (j_)], p0, 0, 0, 0); p1 = __builtin_amdgcn_mfma_f32_32x32x16_bf16(src[1], qf[2 * (j_)], p1, 0, 0, 0); \
                p0 = __builtin_amdgcn_mfma_f32_32x32x16_bf16(src[2], qf[2 * (j_) + 1], p0, 0, 0, 0); p1 = __builtin_amdgcn_mfma_f32_32x32x16_bf16(src[3], qf[2 * (j_) + 1], p1, 0, 0, 0); } while (0)
                ATT_KLOAD(kA, 0); ATT_KLOAD(kB, 1); ATT_SB();
                p0 = z16; p1 = z16;
                ATT_KMM(kA, 0); ATT_SB(); ATT_KLOAD(kA, 2); ATT_SB();
                ATT_KMM(kB, 1); ATT_SB(); ATT_KLOAD(kB, 3); ATT_SB();
                ATT_KMM(kA, 2); ATT_SB(); ATT_KLOAD(kA, 4); ATT_SB();
                ATT_KMM(kB, 3); ATT_SB(); ATT_KLOAD(kB, 5); ATT_SB();
                ATT_KMM(kA, 4); ATT_SB(); ATT_KMM(kB, 5); ATT_SB();
            }
            float off0 = 0.f, off1 = 0.f;
            if (DA) {
                off1 = H32;
                if (tt == 0) off0 = 48.0f * slope2;
                if (tt == tmax) {
                    const float qoff = (float)(qx - 64 * (tt - 1)), dq = qoff - (float)(4 * hi);
#pragma unroll
                    for (int r = 0; r < 16; ++r) { const float cr = (float)((r & 3) + 8 * (r >> 2));
                        p0[r] = (p0[r] - cvec[r]) - slope2 * fabsf(dq - cr); p1[r] = (p1[r] - cvec[r]) - slope2 * fabsf(dq - 32.0f - cr); }
                    off0 = slope2 * qoff; off1 = off0;
                }
            }
            if (tt == 0) {
#pragma unroll
                for (int r = 0; r < 16; ++r) { if (r >= 8) p0[r] = -1e30f; p1[r] = -1e30f; }
            }
            float ra = mx3(p0[0], p0[1], p0[2]), rb = mx3(p1[0], p1[1], p1[2]);
            ra = mx3(ra, p0[3], p0[4]); rb = mx3(rb, p1[3], p1[4]);
#pragma unroll
            for (int r = 5; r < 15; r += 2) { ra = mx3(ra, p0[r], p0[r + 1]); rb = mx3(rb, p1[r], p1[r + 1]); }
            ra = fmaxf(ra, p0[15]); rb = fmaxf(rb, p1[15]);
            const float rm = swap_max(fmaxf(ra + off0, rb + off1));
            const bool skip = DA && __all(rm - mrun < -40.0f);
            if (!skip) {
                const float mn = fmaxf(mrun, rm), alpha = __builtin_amdgcn_exp2f(mrun - mn);
                mrun = mn;
                const float m0 = mn - off0, m1 = mn - off1;
                float sum = 0.f;
#pragma unroll
                for (int r = 0; r < 16; ++r) { p0[r] = __builtin_amdgcn_exp2f(p0[r] - m0); p1[r] = __builtin_amdgcn_exp2f(p1[r] - m1); sum += p0[r] + p1[r]; }
                ATT_SB();
#pragma unroll
                for (int cc = 0; cc < 4; ++cc) ATT_VFRAG(va[cc], cc, 0);
                ATT_SB();
                lrun = lrun * alpha + sum;
                if (__any(alpha != 1.0f)) {
#pragma unroll
                    for (int cc = 0; cc < 4; ++cc)
#pragma unroll
                        for (int r = 0; r < 16; ++r) O[cc][r] *= alpha;
                }
                bf16x8 pf[4]; pf[0] = pack_p(p0, 0); pf[1] = pack_p(p0, 8); pf[2] = pack_p(p1, 0); pf[3] = pack_p(p1, 8);
#define ATT_PVMM(src, kap_) do { _Pragma("unroll") for (int cc = 0; cc < 4; ++cc) O[cc] = __builtin_amdgcn_mfma_f32_32x32x16_bf16(src[cc], pf[kap_], O[cc], 0, 0, 0); } while (0)
#define ATT_PVLD(dst, kap_) do { _Pragma("unroll") for (int cc = 0; cc < 4; ++cc) ATT_VFRAG(dst[cc], cc, kap_); } while (0)
                ATT_SB(); ATT_PVLD(vbf, 1); ATT_SB();
                ATT_PVMM(va, 0); ATT_SB(); ATT_PVLD(va, 2); ATT_SB();
                ATT_PVMM(vbf, 1); ATT_SB(); ATT_PVLD(vbf, 3); ATT_SB();
                ATT_PVMM(va, 2); ATT_SB(); ATT_PVMM(vbf, 3); ATT_SB();
            }
        }
        if (DA) {
            if (tt <= tmax && !wdone) wdone = __all(qbound + 63.0f * slope2 - (mrun + H64) < -40.0f);
            const int vn = vi == 2 ? 0 : vi + 1;
            if (tid == 0) vote[vn] = 0u;
            if (wdone && lane == 0) __hip_atomic_fetch_add(vote + vi, 1u, __ATOMIC_RELAXED, __HIP_MEMORY_SCOPE_WORKGROUP);
        }
        if (tt >= 2) { if (npiece == 6) ATT_WAITBAR(6); else if (npiece == 5) ATT_WAITBAR(5); else ATT_WAITBAR(4); }
        else ATT_WAITBAR(0);
        { const int t_ = bo0; bo0 = bo1; bo1 = bo2; bo2 = t_; }
        if (DA) {
            const unsigned nv = *(volatile LAS unsigned*)(vote + vi);
            vi = vi == 2 ? 0 : vi + 1;
            if (nv == 8u && tt > 0) { ATT_WAITBAR(0); break; }
        }
    }
    if (DA) {
        LAS float* xch = (LAS float*)lds + (size_t)wq * 64 * 64 + lane;
        const float i1 = (comp ? lam : 1.0f) / swap_sum(lrun);
        if (comp == 1) {
#pragma unroll
            for (int cc = 0; cc < 4; ++cc)
#pragma unroll
                for (int r = 0; r < 16; ++r) xch[(cc * 16 + r) * 64] = O[cc][r] * i1;
        }
        __syncthreads();
        if (comp == 0) {
            float ss = 0.f;
#pragma unroll
            for (int cc = 0; cc < 4; ++cc)
#pragma unroll
                for (int r = 0; r < 16; ++r) { const float o = O[cc][r] * i1 - xch[(cc * 16 + r) * 64]; O[cc][r] = o; ss += o * o; if ((r & 7) == 7) asm volatile("" ::: "memory"); }
            ss = swap_sum(ss);
            const float rn = rsqrtf(ss * (1.0f / 128.0f) + EPS) * 0.8f;
            bf16_t* op = T.MIX + qrow * 1024 + 128 * h + 4 * hi;
#pragma unroll
            for (int cc = 0; cc < 4; ++cc)
#pragma unroll
                for (int g = 0; g < 4; ++g) { const f32x4 gs = *(const f32x4*)(T.gsub + 32 * cc + 8 * g + 4 * hi);
                    u32x2 w; w.x = pg8::cvt_pk_bf16(O[cc][4 * g] * rn * gs[0], O[cc][4 * g + 1] * rn * gs[1]); w.y = pg8::cvt_pk_bf16(O[cc][4 * g + 2] * rn * gs[2], O[cc][4 * g + 3] * rn * gs[3]);
                    *(u32x2*)(op + 32 * cc + 8 * g) = w; asm volatile("" ::: "memory"); }
        }
        __syncthreads();
    } else {
        const float i1 = 1.0f / swap_sum(lrun);
        bf16_t* op = T.MIX + qrow * 1024 + 512 + 128 * h + 4 * hi;
#pragma unroll
        for (int cc = 0; cc < 4; ++cc)
#pragma unroll
            for (int g = 0; g < 4; ++g) { u32x2 w; w.x = pg8::cvt_pk_bf16(O[cc][4 * g] * i1, O[cc][4 * g + 1] * i1); w.y = pg8::cvt_pk_bf16(O[cc][4 * g + 2] * i1, O[cc][4 * g + 3] * i1);
                *(u32x2*)(op + 32 * cc + 8 * g) = w; }
    }
}
}

struct Params { const float* in[19]; float* out; unsigned char* ws; float inv_freq[32]; };
constexpr int LDS_BYTES = 131072 + 512;

__device__ __forceinline__ float wave_sum(float v) {
#pragma unroll
    for (int o = 1; o < 64; o <<= 1) v += __shfl_xor(v, o);
    return v;
}
__device__ __forceinline__ int src_col(int kind, int n) {
    if (kind == 0) { if (n < 1920) return n; if (n < 1984) { const int j = n - 1920; return 1920 + (j & 1) * 32 + (j >> 1); } return -1; }
    if (kind == 1) { const int hh = n / 192, d = n % 192; if (d < 128) return n; const int j = d - 128; return 192 * hh + 128 + (j & 1) * 32 + (j >> 1); }
    return n;
}
__device__ __forceinline__ void transpose_item(const float* W, int K, int N, bf16_t* WT, int kind, const float* gain, LAS float* scr, int item, int nblk, int lane) {
    const int kb = item / nblk, nb = item % nblk, k0 = 64 * kb, n0 = 32 * nb;
    const int src = src_col(kind, n0 + (lane & 31));
    const float cs = (kind == 0 && n0 < 512) ? C2_DA : 1.0f;
#pragma unroll 8
    for (int i = 0; i < 32; ++i) { const int kk = 2 * i + (lane >> 5); float v = 0.f; if (src >= 0) v = W[(size_t)(k0 + kk) * N + src]; if (gain) v *= gain[k0 + kk]; scr[kk * 33 + (lane & 31)] = v * cs; }
    asm volatile("s_waitcnt lgkmcnt(0)" ::: "memory");
    const int c = lane & 7;
#pragma unroll
    for (int j = 0; j < 4; ++j) { const int n = (lane >> 3) + 8 * j; const LAS float* s = scr + (8 * c) * 33 + n;
        u32x4 o; o.x = pg8::cvt_pk_bf16(s[0 * 33], s[1 * 33]); o.y = pg8::cvt_pk_bf16(s[2 * 33], s[3 * 33]); o.z = pg8::cvt_pk_bf16(s[4 * 33], s[5 * 33]); o.w = pg8::cvt_pk_bf16(s[6 * 33], s[7 * 33]);
        *(u32x4*)(WT + (size_t)(n0 + n) * K + k0 + 8 * c) = o; }
    asm volatile("s_waitcnt lgkmcnt(0)" ::: "memory");
}

__global__ void __launch_bounds__(512, 2) fwd_megakernel(Params P) {
    extern __shared__ __attribute__((aligned(16))) unsigned char lds_raw[];
    LAS unsigned char* lds = (LAS unsigned char*)lds_raw;
    cg::grid_group grid = cg::this_grid();
    const int tid = threadIdx.x, lane = tid & 63, wave = __builtin_amdgcn_readfirstlane(tid >> 6);
    const int G = gridDim.x, bx = blockIdx.x;
    int vcu = (G % 8 == 0) ? (bx % 8) * (G / 8) + bx / 8 : bx;
    int cid = bx;
#define XIN (P.in[0])
#define RQ ((float*)(P.ws + WS_STAT))
#define RKV (RQ + MALL)
#define SS1 (RQ + 2 * MALL)
#define SS2 (RQ + 3 * MALL)
#define TAB ((float*)(P.ws + WS_TAB))
#define WIN ((bf16_t*)(P.ws + WS_WIN))
#define WQ ((bf16_t*)(P.ws + WS_WQ))
#define WKV ((bf16_t*)(P.ws + WS_WKV))
#define WO ((bf16_t*)(P.ws + WS_WO))
#define W1 ((bf16_t*)(P.ws + WS_W1))
#define W2 ((bf16_t*)(P.ws + WS_W2))
#define U ((bf16_t*)(P.ws + WS_U))
#define MIX ((bf16_t*)(P.ws + WS_MIX))
#define MIXO ((bf16_t*)(P.ws + WS_MIXO))
#define PROJ ((bf16_t*)(P.ws + WS_PROJ))
#define KD ((bf16_t*)(P.ws + WS_KD))
#define VD ((bf16_t*)(P.ws + WS_VD))
#define QM ((bf16_t*)(P.ws + WS_QM))
#define KN ((bf16_t*)(P.ws + WS_KN))
#define VM ((bf16_t*)(P.ws + WS_VM))
#define KR ((bf16_t*)(P.ws + WS_KR))
#define HB ((bf16_t*)(P.ws + WS_H))
#define FB MIX
    const int NGW = G * 8;
    int gw = vcu * 8 + wave;
    unsigned* ctl = (unsigned*)(P.ws + WS_CTL);
    LAS unsigned* misc = (LAS unsigned*)(lds + 131072);
    const unsigned xcc = (unsigned)__builtin_amdgcn_s_getreg((3 << 11) | 20) & 7u;
    if (tid == 0) misc[0] = __hip_atomic_fetch_add(ctl + 16 * xcc, 1u, __ATOMIC_RELAXED, __HIP_MEMORY_SCOPE_AGENT);

#if (PH >> 0) & 1
    {
        LAS float* scr = (LAS float*)(lds + wave * 16384);
        constexpr int I_IN = 16 * 64, I_Q = 4 * 24, I_KV = 2 * 32, I_O = 16 * 32, I_1 = 16 * 128, I_2 = 64 * 32;
        constexpr int NITEMS = I_IN + I_Q + I_KV + I_O + I_1 + I_2;
        for (int it = gw; it < NITEMS; it += NGW) {
            int r = it;
            if (r < I_IN) { transpose_item(P.in[3], 1024, 1984, WIN, 0, nullptr, scr, r, 64, lane); continue; } r -= I_IN;
            if (r < I_Q) { transpose_item(P.in[10], 256, 768, WQ, 1, P.in[9], scr, r, 24, lane); continue; } r -= I_Q;
            if (r < I_KV) { transpose_item(P.in[12], 128, 1024, WKV, 2, P.in[11], scr, r, 32, lane); continue; } r -= I_KV;
            if (r < I_O) { transpose_item(P.in[13], 1024, 1024, WO, 2, nullptr, scr, r, 32, lane); continue; } r -= I_O;
            if (r < I_1) { transpose_item(P.in[16], 1024, 4096, W1, 2, nullptr, scr, r, 128, lane); continue; } r -= I_1;
            transpose_item(P.in[17], 4096, 1024, W2, 2, nullptr, scr, r, 32, lane);
        }
        f32x4 gp[4];
#pragma unroll
        for (int j = 0; j < 4; ++j) gp[j] = *(const f32x4*)(P.in[2] + 4 * lane + 256 * j);
        for (int m = gw; m < MALL; m += NGW) {
            unsigned long long* o8 = (unsigned long long*)(U + (size_t)m * 1024) + lane;
            if (m >= MX + N_META) {
#pragma unroll
                for (int j = 0; j < 4; ++j) o8[64 * j] = 0ull;
                continue; }
            const float* src = (m < MX) ? XIN + (size_t)m * 1024 : P.in[1] + (size_t)(m - MX) * 1024;
            f32x4 v[4]; float s = 0.f;
#pragma unroll
            for (int j = 0; j < 4; ++j) { v[j] = *(const f32x4*)(src + 4 * lane + 256 * j); s += (v[j][0] * v[j][0] + v[j][1] * v[j][1]) + (v[j][2] * v[j][2] + v[j][3] * v[j][3]); }
            const float rs = rsqrtf(wave_sum(s) * (1.0f / 1024.0f) + EPS);
#pragma unroll
            for (int j = 0; j < 4; ++j) { const f32x4 y = v[j] * rs * gp[j];
                o8[64 * j] = (unsigned long long)pg8::cvt_pk_bf16(y[0], y[1]) | ((unsigned long long)pg8::cvt_pk_bf16(y[2], y[3]) << 32); }
        }
        const int gt = vcu * 512 + tid, NGT = G * 512;
        for (int i = gt; i < 4 * MALL; i += NGT) RQ[i] = 0.f;
        for (int i = gt; i < LTOT * 32; i += NGT) {
            const int pos = i >> 5, fi = i & 31;
            const float ang = (float)pos * P.inv_freq[fi];
            const double a = (double)ang; const double k = rint(a * 0.6366197723675814); const double r = fma(-k, 1.5707963267948966, a) - k * 6.123233995736766e-17;
            const double r2 = r * r;
            double sn = r * (1.0 + r2 * (-1.0 / 6 + r2 * (1.0 / 120 + r2 * (-1.0 / 5040 + r2 * (1.0 / 362880 + r2 * (-1.0 / 39916800 + r2 * (1.0 / 6227020800.0)))))));
            double cs = 1.0 + r2 * (-0.5 + r2 * (1.0 / 24 + r2 * (-1.0 / 720 + r2 * (1.0 / 40320 + r2 * (-1.0 / 3628800 + r2 * (1.0 / 479001600.0))))));
            const int qd = ((int)k) & 3;
            double c_, s_;
            if (qd == 0) { c_ = cs; s_ = sn; } else if (qd == 1) { c_ = -sn; s_ = cs; } else if (qd == 2) { c_ = -cs; s_ = -sn; } else { c_ = sn; s_ = -cs; }
            TAB[2 * i] = (float)c_; TAB[2 * i + 1] = (float)s_;
        }
    }
#endif
    grid.sync();
    if (tid == 0) { unsigned base = 0, n[8];
#pragma unroll
        for (int j = 0; j < 8; ++j) n[j] = __hip_atomic_load(ctl + 16 * j, __ATOMIC_RELAXED, __HIP_MEMORY_SCOPE_AGENT);
#pragma unroll
        for (int j = 0; j < 8; ++j) if ((unsigned)j < xcc) base += n[j];
        misc[1] = base + misc[0]; }
    __syncthreads();
    if (G == 256) { vcu = __builtin_amdgcn_readfirstlane((int)misc[1]); cid = (vcu & 31) * 8 + (vcu >> 5); gw = vcu * 8 + wave; }

#if (PH >> 1) & 1
    {
        pg8::Gemm g{U, WIN, MALL, NPROJ, 1024, 1024}; pg8::StaticOrder S; S.init(MALL, NPROJ, G, cid);
        pg8::EpiIn E{PROJ, KD, VD, KR, RQ, RKV, TAB};
        pg8::gemm_phase<pg8::EpiIn, pg8::StaticOrder, true, true>(lds, g, S, E);
    }
#endif
    grid.sync();

#if (PH >> 2) & 1
    {
        float mx[4] = {0.f, 0.f, 0.f, 0.f};
        for (int m = gw; m < MX + N_META; m += NGW) {
#pragma unroll
            for (int hh = 0; hh < 4; ++hh) { const unsigned w = *((const unsigned*)(KD + ((size_t)hh * MALL + m) * 128) + lane);
                const float a = __uint_as_float(w << 16), c = __uint_as_float(w & 0xffff0000u); float sq = a * a + c * c;
#pragma unroll
                for (int o = 1; o < 32; o <<= 1) sq += __shfl_xor(sq, o);
                mx[hh] = fmaxf(mx[hh], sq); }
        }
        if ((lane & 31) == 0) {
#pragma unroll
            for (int hh = 0; hh < 4; ++hh) __hip_atomic_fetch_max(ctl + 128 + 2 * hh + (lane >> 5), __float_as_uint(mx[hh]), __ATOMIC_RELAXED, __HIP_MEMORY_SCOPE_AGENT);
        }
    }
    {
        pg8::Gemm g{PROJ + 512, WQ, MX, 768, 256, PPITCH}; pg8::StaticOrder S; S.init(MX, 768, G, cid);
        pg8::EpiQ E{QM, RQ, TAB};
        pg8::gemm_phase<pg8::EpiQ, pg8::StaticOrder, true, true>(lds, g, S, E);
    }
    {
        pg8::Gemm g{PROJ + 768, WKV, MALL, 1024, 128, PPITCH}; pg8::StaticOrder S; S.init(MALL, 1024, G, (cid + 128) % G);
        pg8::EpiKV E{KN, VM, RKV};
        pg8::gemm_phase<pg8::EpiKV, pg8::StaticOrder, true, true>(lds, g, S, E);
    }
#endif
    grid.sync();

#if (PH >> 3) & 1
    {
        float a = P.in[4][lane] * P.in[5][lane], c = P.in[6][lane] * P.in[7][lane];
        a = wave_sum(a); c = wave_sum(c);
        const float lam = expf(a) - expf(c) + 0.2f;
        const att::Tensors T{PROJ, KD, VD, QM, KN, VM, KR, MIX, P.in[8], ctl + 128};
        if (G == 256) {
            const int b = vcu >> 5, i = vcu & 31;
            for (int j = 0; j < 6; ++j) {
                if (j == 2) att::attn_unit<false>(lds, T, b, i < 16 ? 0 : 1, i & 15, 0.f);
                else if (j == 5) att::attn_unit<false>(lds, T, b, i < 16 ? 2 : 3, 15 - (i & 15), 0.f);
                else { const int hh = j < 2 ? j : j - 1; att::attn_unit<true>(lds, T, b, hh, (hh == 0 || hh == 3) ? i : 31 - i, lam); }
            }
        }
    }
#endif
    grid.sync();

#if (PH >> 4) & 1
    {
        pg8::Gemm g{MIX, WO, MX, 1024, 1024, 1024}; pg8::StaticOrder S; S.init(MX, 1024, G, cid);
        pg8::EpiSS E{MIXO, 1024, SS1};
        pg8::gemm_phase<pg8::EpiSS, pg8::StaticOrder, true, true>(lds, g, S, E);
    }
#endif
    grid.sync();

#if (PH >> 5) & 1
    {
        f32x4 g1[4], g2[4];
#pragma unroll
        for (int j = 0; j < 4; ++j) { g1[j] = *(const f32x4*)(P.in[14] + 4 * lane + 256 * j); g2[j] = *(const f32x4*)(P.in[15] + 4 * lane + 256 * j); }
        for (int m = gw; m < MX; m += NGW) {
            const float r1 = rsqrtf(SS1[m] * (1.0f / 1024.0f) + EPS);
            const unsigned long long* mi = (const unsigned long long*)(MIXO + (size_t)m * 1024) + lane;
            f32x4 hv[4]; float s = 0.f;
#pragma unroll
            for (int j = 0; j < 4; ++j) { const f32x4 xv = *(const f32x4*)(XIN + (size_t)m * 1024 + 4 * lane + 256 * j); const unsigned long long w = mi[64 * j];
                f32x4 mv; mv[0] = __uint_as_float((unsigned)(w & 0xffffu) << 16); mv[1] = __uint_as_float((unsigned)w & 0xffff0000u); mv[2] = __uint_as_float((unsigned)((w >> 32) & 0xffffu) << 16); mv[3] = __uint_as_float((unsigned)(w >> 32) & 0xffff0000u);
                hv[j] = xv + mv * r1 * g1[j]; s += (hv[j][0] * hv[j][0] + hv[j][1] * hv[j][1]) + (hv[j][2] * hv[j][2] + hv[j][3] * hv[j][3]);
                *(f32x4*)(P.out + (size_t)m * 1024 + 4 * lane + 256 * j) = hv[j]; }
            const float rs = rsqrtf(wave_sum(s) * (1.0f / 1024.0f) + EPS);
            unsigned long long* o8 = (unsigned long long*)(U + (size_t)m * 1024) + lane;
#pragma unroll
            for (int j = 0; j < 4; ++j) { const f32x4 y = hv[j] * rs * g2[j];
                o8[64 * j] = (unsigned long long)pg8::cvt_pk_bf16(y[0], y[1]) | ((unsigned long long)pg8::cvt_pk_bf16(y[2], y[3]) << 32); }
        }
    }
#endif
    grid.sync();

#if (PH >> 6) & 1
    {
        pg8::Gemm g{U, W1, MX, D_FF, 1024, 1024}; pg8::StaticOrder S; S.init(MX, D_FF, G, cid);
        pg8::EpiRelu2 E{HB, D_FF};
        pg8::gemm_phase<pg8::EpiRelu2, pg8::StaticOrder, true, true>(lds, g, S, E);
    }
#endif
    grid.sync();

#if (PH >> 7) & 1
    {
        pg8::Gemm g{HB, W2, MX, 1024, D_FF, D_FF}; pg8::StaticOrder S; S.init(MX, 1024, G, cid);
        pg8::EpiSS E{FB, 1024, SS2};
        pg8::gemm_phase<pg8::EpiSS, pg8::StaticOrder, true, true>(lds, g, S, E);
    }
#endif
    grid.sync();

#if (PH >> 8) & 1
    {
        f32x4 g3[4];
#pragma unroll
        for (int j = 0; j < 4; ++j) g3[j] = *(const f32x4*)(P.in[18] + 4 * lane + 256 * j);
        for (int m = gw; m < MX; m += NGW) {
            const float r2 = rsqrtf(SS2[m] * (1.0f / 1024.0f) + EPS);
            const unsigned long long* fi = (const unsigned long long*)(FB + (size_t)m * 1024) + lane;
#pragma unroll
            for (int j = 0; j < 4; ++j) { float* op = P.out + (size_t)m * 1024 + 4 * lane + 256 * j; const f32x4 hv = *(const f32x4*)op; const unsigned long long w = fi[64 * j];
                f32x4 mv; mv[0] = __uint_as_float((unsigned)(w & 0xffffu) << 16); mv[1] = __uint_as_float((unsigned)w & 0xffff0000u); mv[2] = __uint_as_float((unsigned)((w >> 32) & 0xffffu) << 16); mv[3] = __uint_as_float((unsigned)(w >> 32) & 0xffff0000u);
                *(f32x4*)op = hv + mv * r2 * g3[j]; }
        }
    }
#endif
}

extern "C" void kernel_launch(void* const* d_in, const int* in_sizes, int n_in, void* d_out, int out_size, void* d_ws, size_t ws_size, hipStream_t stream) {
    static int grid = 0;
    if (grid == 0) {
        if (n_in != 19 || in_sizes[0] != MX * D_MODEL || out_size != MX * D_MODEL || ws_size < WS_END) {
            fprintf(stderr, "kernel_launch: unexpected shapes (n_in %d, in0 %d, out %d, ws %zu); nothing launched\n", n_in, n_in > 0 ? in_sizes[0] : -1, out_size, ws_size); grid = -1; return; }
        int dev = 0, cus = 0, per_cu = 0;
        hipGetDevice(&dev);
        hipDeviceGetAttribute(&cus, hipDeviceAttributeMultiprocessorCount, dev);
        if (hipFuncSetAttribute((const void*)fwd_megakernel, hipFuncAttributeMaxDynamicSharedMemorySize, LDS_BYTES) != hipSuccess) { fprintf(stderr, "kernel_launch: hipFuncSetAttribute failed\n"); grid = -1; return; }
        if (hipOccupancyMaxActiveBlocksPerMultiprocessor(&per_cu, (const void*)fwd_megakernel, 512, LDS_BYTES) != hipSuccess || per_cu < 1) { fprintf(stderr, "kernel_launch: occupancy query failed (%d)\n", per_cu); grid = -1; return; }
        grid = cus;
        fprintf(stderr, "kernel_launch: cus %d per_cu %d grid %d\n", cus, per_cu, grid);
    }
    if (grid < 0) return;
    Params p{};
    for (int i = 0; i < 19; ++i) p.in[i] = (const float*)d_in[i];
    p.out = (float*)d_out; p.ws = (unsigned char*)d_ws;
    for (int i = 0; i < 32; ++i) p.inv_freq[i] = 1.0f / powf(10000.0f, (float)(2 * i) / 64.0f);
    if (hipMemsetAsync((char*)d_ws + WS_CTL, 0, 1024, stream) != hipSuccess) { fprintf(stderr, "kernel_launch: memset failed\n"); return; }
    void* args[] = {&p};
    hipError_t e = hipLaunchCooperativeKernel((const void*)fwd_megakernel, dim3(grid), dim3(512), args, LDS_BYTES, stream);
    if (e != hipSuccess) fprintf(stderr, "cooperative launch failed: %s (grid %d)\n", hipGetErrorString(e), grid);
}
```

```cpp
#ifndef PH
#define PH 0x1ff
#endif
#include <hip/hip_runtime.h>
#include <hip/hip_cooperative_groups.h>
#include <cstdio>
#include <cstdint>
#include <cmath>
namespace cg = cooperative_groups;

#define LAS __attribute__((address_space(3)))
typedef unsigned short bf16_t;
typedef short bf16x8 __attribute__((ext_vector_type(8)));
typedef float f32x4 __attribute__((ext_vector_type(4)));
typedef float f32x2 __attribute__((ext_vector_type(2)));
typedef float f32x16 __attribute__((ext_vector_type(16)));
typedef unsigned u32x4 __attribute__((ext_vector_type(4)));
typedef unsigned u32x2 __attribute__((ext_vector_type(2)));
typedef __bf16 bf16x2_t __attribute__((ext_vector_type(2)));
typedef short v4i16_t __attribute__((ext_vector_type(4)));

constexpr int D_MODEL = 1024, BATCH = 8, SEQ = 4096, N_META = 16, LTOT = SEQ + N_META;
constexpr int MX = BATCH * SEQ;
constexpr int MALL = MX + 256;
constexpr int NPROJ = 2048;
constexpr int PPITCH = 1024;
constexpr int D_FF = 4096;
constexpr float EPS = 1e-6f;
constexpr float LOG2E = 1.4426950408889634f;
constexpr float C2_DA = 0.125f * LOG2E;
constexpr float C2_MLA = 0.07216878364870322f * LOG2E;

constexpr size_t MiB = 1u << 20;
constexpr size_t WS_STAT = 0;
constexpr size_t WS_TAB = 1 * MiB;
constexpr size_t WS_CTL = 3 * MiB;
constexpr size_t WS_WIN = 4 * MiB;
constexpr size_t WS_WQ = 8 * MiB;
constexpr size_t WS_WKV = 9 * MiB;
constexpr size_t WS_WO = 10 * MiB;
constexpr size_t WS_W1 = 12 * MiB;
constexpr size_t WS_W2 = 20 * MiB;
constexpr size_t WS_U = 32 * MiB;
constexpr size_t WS_MIX = 100 * MiB;
constexpr size_t WS_MIXO = 164 * MiB;
constexpr size_t WS_PROJ = 228 * MiB;
constexpr size_t WS_KD = 293 * MiB;
constexpr size_t WS_VD = 326 * MiB;
constexpr size_t WS_QM = 359 * MiB;
constexpr size_t WS_KN = 408 * MiB;
constexpr size_t WS_VM = 441 * MiB;
constexpr size_t WS_KR = 474 * MiB;
constexpr size_t WS_H = 228 * MiB;
constexpr size_t WS_END = 484 * MiB;

namespace pg8 {
constexpr int BM = 256, BK = 64, HALF = 128, HTB = HALF * BK * 2, STAGE_BYTES = 8 * HTB, NXCD = 8, WGM = 8;
__host__ __device__ __forceinline__ int lds_byte(int r, int c) { const int st = (r >> 4) * 2 + (c >> 5), rr = r & 15, cc = c & 31, ob = rr * 64 + cc * 2; return st * 1024 + (ob ^ (((ob >> 9) & 1) << 5)); }
__host__ __device__ __forceinline__ void stage_rc(int b, int& R, int& C) { const int st = b / 1024, sb = b % 1024, swz = sb ^ (((sb >> 9) & 1) << 5); R = (st >> 1) * 16 + swz / 64; C = (st & 1) * 32 + (swz % 64) / 2; }
__host__ __device__ __forceinline__ int perm32(int rho) { const int n = rho >> 4, i = rho & 15; return 8 * (i >> 2) + 4 * n + (i & 3); }
struct Unit { int pm, pn; };
struct Gemm { const bf16_t* A; const bf16_t* Bt; int M, N, K, lda; };
struct StaticOrder {
    int nM, nN, nwg, G, c;
    __host__ __device__ void init(int M, int N, int G_, int c_) { nM = M / BM; nN = N / BM; nwg = nM * nN; G = G_; c = c_; }
    __host__ __device__ bool next(int i, Unit& u) const {
        const long L = (long)i * G + c; if (L >= nwg) return false;
        int wgid = (int)L; { const int q = nwg / NXCD, r = nwg % NXCD, xcd = wgid % NXCD, off = wgid / NXCD; wgid = (xcd < r ? xcd * (q + 1) : r * (q + 1) + (xcd - r) * q) + off; }
        const int nig = WGM * nN, gid = wgid / nig, fm = gid * WGM, gsz = (nM - fm) < WGM ? (nM - fm) : WGM;
        u.pm = fm + ((wgid % nig) % gsz); u.pn = (wgid % nig) / gsz; return true;
    }
    __device__ __forceinline__ void a_ready(const Unit&) const {}
    __device__ __forceinline__ void done(const Unit&) const {}
};
__device__ __forceinline__ unsigned cvt_pk_bf16(float lo, float hi) { f32x2 v = {lo, hi}; bf16x2_t b = __builtin_convertvector(v, bf16x2_t); return __builtin_bit_cast(unsigned, b); }
__device__ __forceinline__ u32x4 pack8(const f32x4& v0, const f32x4& v1) { u32x4 w; w.x = cvt_pk_bf16(v0[0], v0[1]); w.y = cvt_pk_bf16(v0[2], v0[3]); w.z = cvt_pk_bf16(v1[0], v1[1]); w.w = cvt_pk_bf16(v1[2], v1[3]); return w; }
__device__ __forceinline__ float ssq8(const f32x4& a, const f32x4& b) { return (a[0] * a[0] + a[1] * a[1]) + (a[2] * a[2] + a[3] * a[3]) + (b[0] * b[0] + b[1] * b[1]) + (b[2] * b[2] + b[3] * b[3]); }
__device__ __forceinline__ void rope8(f32x4& v0, f32x4& v1, const float* tab, int pos, int i0) {
    const f32x4 t0 = *(const f32x4*)(tab + ((size_t)pos * 32 + i0) * 2), t1 = *(const f32x4*)(tab + ((size_t)pos * 32 + i0 + 2) * 2);
    f32x4 a, b;
    a[0] = v0[0] * t0[0] - v0[1] * t0[1]; a[1] = v0[1] * t0[0] + v0[0] * t0[1];
    a[2] = v0[2] * t0[2] - v0[3] * t0[3]; a[3] = v0[3] * t0[2] + v0[2] * t0[3];
    b[0] = v1[0] * t1[0] - v1[1] * t1[1]; b[1] = v1[1] * t1[0] + v1[0] * t1[1];
    b[2] = v1[2] * t1[2] - v1[3] * t1[3]; b[3] = v1[3] * t1[2] + v1[2] * t1[3];
    v0 = a; v1 = b;
}

struct EpiIn {
    static constexpr bool PERM = true, AFTER_DRAIN = false;
    bf16_t* PROJ; bf16_t* KD; bf16_t* VD; bf16_t* KR; float* RQ; float* RKV; const float* tab; unsigned* kmax;
    __device__ __forceinline__ void operator()(const f32x4 (&acc)[2][2][4][2], const Unit& u, int wr, int wc, int fr, int fq) const {
        const int row0 = u.pm * BM + wr * 64 + fr, cw = wc * 32 + 8 * fq, pn = u.pn;
        const bool kt = pn == 2 || pn == 3; float km0 = 0.f, km1 = 0.f;
        bf16_t* base0; bf16_t* base1; int pitch0, pitch1;
        if (pn < 2) { base0 = PROJ + pn * BM; base1 = base0 + HALF; pitch0 = pitch1 = PPITCH; }
        else if (pn < 6) { base0 = (pn < 4 ? KD : VD) + (size_t)((pn & 1) * 2) * MALL * 128; base1 = base0 + (size_t)MALL * 128; pitch0 = pitch1 = 128; }
        else if (pn == 6) { base0 = PROJ + 512; base1 = base0 + HALF; pitch0 = pitch1 = PPITCH; }
        else { base0 = PROJ + 768; pitch0 = PPITCH; base1 = KR; pitch1 = 64; }
        const bool stat = pn >= 6, kr = pn == 7;
#pragma unroll
        for (int ai = 0; ai < 2; ++ai)
#pragma unroll
            for (int m = 0; m < 4; ++m) {
                const int row = row0 + ai * HALF + m * 16;
                { const f32x4 v0 = acc[ai][0][m][0], v1 = acc[ai][0][m][1]; *(u32x4*)(base0 + (size_t)row * pitch0 + cw) = pack8(v0, v1);
                  f32x4 w0 = acc[ai][1][m][0], w1 = acc[ai][1][m][1];
                  if (kr) { if (wc < 2) { const int pos = row < MX ? N_META + (row & (SEQ - 1)) : ((row - MX) < N_META ? (row - MX) : 0);
                                rope8(w0, w1, tab, pos, 16 * wc + 4 * fq); *(u32x4*)(base1 + (size_t)row * pitch1 + cw) = pack8(w0, w1); } }
                  else *(u32x4*)(base1 + (size_t)row * pitch1 + cw) = pack8(w0, w1);
                  if (kt) { float s0 = ssq8(v0, v1), s1 = ssq8(w0, w1); s0 += __shfl_xor(s0, 16); s0 += __shfl_xor(s0, 32); s1 += __shfl_xor(s1, 16); s1 += __shfl_xor(s1, 32); km0 = fmaxf(km0, s0); km1 = fmaxf(km1, s1); }
                  if (stat) { float ss = ssq8(v0, v1); if (!kr) ss += ssq8(w0, w1);
                      ss += __shfl_xor(ss, 16); ss += __shfl_xor(ss, 32);
                      if (fq == 0) __hip_atomic_fetch_add((kr ? RKV : RQ) + row, ss, __ATOMIC_RELAXED, __HIP_MEMORY_SCOPE_AGENT); } }
                asm volatile("" ::: "memory");
            }
        if (kt) {
#pragma unroll
            for (int o = 1; o < 16; o <<= 1) { km0 = fmaxf(km0, __shfl_xor(km0, o)); km1 = fmaxf(km1, __shfl_xor(km1, o)); }
            if (fr == 0 && fq == 0) { const int h0 = (pn & 1) * 2;
                __hip_atomic_fetch_max(kmax + 2 * (2 * h0 + (wc >> 1)) + (wc & 1), __float_as_uint(km0), __ATOMIC_RELAXED, __HIP_MEMORY_SCOPE_AGENT);
                __hip_atomic_fetch_max(kmax + 2 * (2 * (h0 + 1) + (wc >> 1)) + (wc & 1), __float_as_uint(km1), __ATOMIC_RELAXED, __HIP_MEMORY_SCOPE_AGENT); }
        }
    }
};
struct EpiQ {
    static constexpr bool PERM = true, AFTER_DRAIN = false;
    bf16_t* QM; const float* RQ; const float* tab;
    __device__ __forceinline__ void operator()(const f32x4 (&acc)[2][2][4][2], const Unit& u, int wr, int wc, int fr, int fq) const {
        const int row0 = u.pm * BM + wr * 64 + fr, colt = u.pn * BM + wc * 32 + 8 * fq;
        const int blk0 = (8 * u.pn + wc) % 6, blk1 = (8 * u.pn + 4 + wc) % 6;
#pragma unroll
        for (int ai = 0; ai < 2; ++ai)
#pragma unroll
            for (int m = 0; m < 4; ++m) {
                const int row = row0 + ai * HALF + m * 16; const float sc = rsqrtf(RQ[row] * (1.0f / 256.0f) + EPS) * C2_MLA; const int pos = N_META + (row & (SEQ - 1));
                { f32x4 v0 = acc[ai][0][m][0] * sc, v1 = acc[ai][0][m][1] * sc;
                  if (blk0 >= 4) rope8(v0, v1, tab, pos, (blk0 - 4) * 16 + 4 * fq);
                  *(u32x4*)(QM + (size_t)row * 768 + colt) = pack8(v0, v1); }
                { f32x4 v0 = acc[ai][1][m][0] * sc, v1 = acc[ai][1][m][1] * sc;
                  if (blk1 >= 4) rope8(v0, v1, tab, pos, (blk1 - 4) * 16 + 4 * fq);
                  *(u32x4*)(QM + (size_t)row * 768 + colt + HALF) = pack8(v0, v1); }
                asm volatile("" ::: "memory");
            }
    }
};
struct EpiKV {
    static constexpr bool PERM = true, AFTER_DRAIN = false;
    bf16_t* KN; bf16_t* VM; const float* RKV;
    __device__ __forceinline__ void operator()(const f32x4 (&acc)[2][2][4][2], const Unit& u, int wr, int wc, int fr, int fq) const {
        const int row0 = u.pm * BM + wr * 64 + fr, c0 = wc * 32 + 8 * fq;
#pragma unroll
        for (int ai = 0; ai < 2; ++ai)
#pragma unroll
            for (int m = 0; m < 4; ++m) {
                const int row = row0 + ai * HALF + m * 16; const float sc = rsqrtf(RKV[row] * (1.0f / 128.0f) + EPS);
                *(u32x4*)(KN + ((size_t)u.pn * MALL + row) * 128 + c0) = pack8(acc[ai][0][m][0] * sc, acc[ai][0][m][1] * sc);
                *(u32x4*)(VM + ((size_t)u.pn * MALL + row) * 128 + c0) = pack8(acc[ai][1][m][0] * sc, acc[ai][1][m][1] * sc);
                asm volatile("" ::: "memory");
            }
    }
};
struct EpiSS {
    static constexpr bool PERM = true, AFTER_DRAIN = false;
    bf16_t* O; int ldc; float* SS;
    __device__ __forceinline__ void operator()(const f32x4 (&acc)[2][2][4][2], const Unit& u, int wr, int wc, int fr, int fq) const {
        const int row0 = u.pm * BM + wr * 64 + fr, colt = u.pn * BM + wc * 32 + 8 * fq;
#pragma unroll
        for (int ai = 0; ai < 2; ++ai)
#pragma unroll
            for (int m = 0; m < 4; ++m) {
                const int row = row0 + ai * HALF + m * 16; float ss = 0.f;
#pragma unroll
                for (int bj = 0; bj < 2; ++bj) { const f32x4 v0 = acc[ai][bj][m][0], v1 = acc[ai][bj][m][1];
                    *(u32x4*)(O + (size_t)row * ldc + colt + bj * HALF) = pack8(v0, v1); ss += ssq8(v0, v1); }
                ss += __shfl_xor(ss, 16); ss += __shfl_xor(ss, 32);
                if (fq == 0) __hip_atomic_fetch_add(SS + row, ss, __ATOMIC_RELAXED, __HIP_MEMORY_SCOPE_AGENT);
            }
    }
};
struct EpiRelu2 {
    static constexpr bool PERM = true, AFTER_DRAIN = false;
    bf16_t* O; int ldc;
    __device__ __forceinline__ void operator()(const f32x4 (&acc)[2][2][4][2], const Unit& u, int wr, int wc, int fr, int fq) const {
        const int row0 = u.pm * BM + wr * 64 + fr, colt = u.pn * BM + wc * 32 + 8 * fq;
#pragma unroll
        for (int ai = 0; ai < 2; ++ai)
#pragma unroll
            for (int m = 0; m < 4; ++m) {
                const int row = row0 + ai * HALF + m * 16;
#pragma unroll
                for (int bj = 0; bj < 2; ++bj) { f32x4 v0 = acc[ai][bj][m][0], v1 = acc[ai][bj][m][1];
#pragma unroll
                    for (int e = 0; e < 4; ++e) { const float a = fmaxf(v0[e], 0.f), b = fmaxf(v1[e], 0.f); v0[e] = a * a; v1[e] = b * b; }
                    *(u32x4*)(O + (size_t)row * ldc + colt + bj * HALF) = pack8(v0, v1); }
            }
    }
};

template <class Epi, class Sched, bool ALIGN_EPI = false, bool SP2 = false>
__device__ __forceinline__ void gemm_phase(LAS unsigned char* lds, const Gemm g, const Sched& S, const Epi& E) {
    int tid_ = threadIdx.x; asm volatile("" : "+v"(tid_));
    const int tid = tid_, wid = __builtin_amdgcn_readfirstlane(tid >> 6), lane = tid & 63, wr = wid >> 2, wc = wid & 3, fr = lane & 15, fq = lane >> 4;
    int K_ = g.K; asm volatile("" : "+s"(K_));
    const int K = K_, nt = K / BK, lda = g.lda;
    unsigned voffA[2], voffB[2];
#pragma unroll
    for (int i = 0; i < 2; ++i) { int R, C; stage_rc(tid * 16 + i * 8192, R, C); const int Rb = Epi::PERM ? ((R & ~31) + perm32(R & 31)) : R;
        voffA[i] = (unsigned)(R * lda + C) * 2u; voffB[i] = (unsigned)(Rb * K + C) * 2u; }
    const size_t kstep = (size_t)(BK * 2);
    const size_t hstepA = (size_t)HALF * lda * 2, hstepB = (size_t)HALF * K * 2;
    const size_t tstepA = 2 * hstepA, tstepB = 2 * hstepB;
    const unsigned ldsw = (unsigned)wid * 1024u;
    const int aoff = lds_byte(wr * 64 + fr, fq * 8), boff = lds_byte(wc * 32 + fr, fq * 8);
#define PG8_SA(b, h) (((b) * 2 + (h)) * HTB)
#define PG8_SB(b, h) ((4 + (b) * 2 + (h)) * HTB)
#define PG8_STAGE(bufoff, gbase, voff) do { _Pragma("unroll") for (int _i = 0; _i < 2; ++_i) \
        __builtin_amdgcn_global_load_lds((const unsigned*)((const char*)(gbase) + (voff)[_i]), (LAS unsigned*)(lds + (bufoff) + ldsw + _i * 8192), 16, 0, 0); } while (0)
#define PG8_LDA(dst, b, h) do { _Pragma("unroll") for (int m = 0; m < 4; ++m) _Pragma("unroll") for (int k = 0; k < 2; ++k) dst[m][k] = *(const LAS bf16x8*)(lds + PG8_SA(b, h) + aoff + m * 2048 + k * 1024); } while (0)
#define PG8_LDB(dst, b, h) do { _Pragma("unroll") for (int n = 0; n < 2; ++n) _Pragma("unroll") for (int k = 0; k < 2; ++k) dst[n][k] = *(const LAS bf16x8*)(lds + PG8_SB(b, h) + boff + n * 2048 + k * 1024); } while (0)
#define PG8_MMA(ai, bj, At, Bt) do { __builtin_amdgcn_s_setprio(1); _Pragma("unroll") for (int m = 0; m < 4; ++m) _Pragma("unroll") for (int n = 0; n < 2; ++n) _Pragma("unroll") for (int k = 0; k < 2; ++k) \
        acc[ai][bj][m][n] = __builtin_amdgcn_mfma_f32_16x16x32_bf16(Bt[n][k], At[m][k], acc[ai][bj][m][n], 0, 0, 0); __builtin_amdgcn_s_setprio(0); } while (0)
#define PG8_WAIT_V(n) asm volatile("s_waitcnt vmcnt(" #n ")" ::: "memory")
#define PG8_WAIT_L(n) asm volatile("s_waitcnt lgkmcnt(" #n ")" ::: "memory")
#define PG8_BAR __builtin_amdgcn_s_barrier()
#define PG8_SCHED __builtin_amdgcn_sched_barrier(0)
    Unit cur, nxt; int ui = 0;
    if (!S.next(0, cur)) return;
    f32x4 acc[2][2][4][2];
#pragma unroll
    for (int a = 0; a < 2; ++a)
#pragma unroll
        for (int b = 0; b < 2; ++b)
#pragma unroll
            for (int m = 0; m < 4; ++m)
#pragma unroll
                for (int n = 0; n < 2; ++n) acc[a][b][m][n] = (f32x4){0.f, 0.f, 0.f, 0.f};
    bf16x8 At[4][2], B0[2][2], B1[2][2];
    const char* cA = (const char*)g.A + (size_t)cur.pm * tstepA; const char* cB = (const char*)g.Bt + (size_t)cur.pn * tstepB;
    S.a_ready(cur);
    if constexpr (SP2) {
        PG8_STAGE(PG8_SB(0, 0), cB, voffB); PG8_STAGE(PG8_SB(0, 1), cB + hstepB, voffB); PG8_STAGE(PG8_SA(0, 0), cA, voffA); PG8_STAGE(PG8_SA(0, 1), cA + hstepA, voffA);
        if (wr == 1) PG8_BAR;
        PG8_WAIT_V(2); PG8_BAR;
        PG8_STAGE(PG8_SB(1, 0), cB + kstep, voffB); PG8_STAGE(PG8_SA(1, 0), cA + kstep, voffA); PG8_STAGE(PG8_SB(1, 1), cB + hstepB + kstep, voffB);
        PG8_WAIT_V(6); PG8_BAR;
    } else {
        PG8_STAGE(PG8_SB(0, 0), cB, voffB); PG8_STAGE(PG8_SA(0, 0), cA, voffA); PG8_STAGE(PG8_SB(0, 1), cB + hstepB, voffB); PG8_STAGE(PG8_SA(0, 1), cA + hstepA, voffA);
        if (wr == 1) PG8_BAR;
        PG8_WAIT_V(4); PG8_BAR;
        PG8_STAGE(PG8_SB(1, 0), cB + kstep, voffB); PG8_STAGE(PG8_SA(1, 0), cA + kstep, voffA); PG8_STAGE(PG8_SB(1, 1), cB + hstepB + kstep, voffB);
        PG8_WAIT_V(6); PG8_BAR;
    }
    for (;;) {
        const bool has_next = S.next(ui + 1, nxt);
        const char* nA = has_next ? (const char*)g.A + (size_t)nxt.pm * tstepA : cA; const char* nB = has_next ? (const char*)g.Bt + (size_t)nxt.pn * tstepB : cB;
#pragma clang loop unroll(disable)
        for (int t = 0; t < nt; t += 2) {
            const bool last = (t == nt - 2);
            const char* a1 = cA + (size_t)(t + 1) * kstep;
            const char* a2 = last ? nA : cA + (size_t)(t + 2) * kstep; const char* b2 = last ? nB : cB + (size_t)(t + 2) * kstep;
            const char* a3 = a2 + kstep; const char* b3 = b2 + kstep;
            if (last && has_next) S.a_ready(nxt);
            if constexpr (SP2) {
            PG8_LDB(B0, 0, 0); PG8_LDB(B1, 0, 1); PG8_SCHED; PG8_LDA(At, 0, 0); PG8_STAGE(PG8_SA(1, 1), a1 + hstepA, voffA);
            PG8_WAIT_V(8); PG8_WAIT_L(0); PG8_BAR; PG8_MMA(0, 0, At, B0); PG8_MMA(0, 1, At, B1); PG8_BAR; PG8_SCHED;
            PG8_LDA(At, 0, 1); PG8_STAGE(PG8_SB(0, 0), b2, voffB); PG8_STAGE(PG8_SB(0, 1), b2 + hstepB, voffB); PG8_STAGE(PG8_SA(0, 0), a2, voffA);
            PG8_WAIT_V(8); PG8_WAIT_L(0); PG8_BAR; PG8_MMA(1, 0, At, B0); PG8_MMA(1, 1, At, B1); PG8_BAR; PG8_SCHED;
            PG8_LDB(B0, 1, 0); PG8_LDB(B1, 1, 1); PG8_SCHED; PG8_LDA(At, 1, 0); PG8_STAGE(PG8_SA(0, 1), a2 + hstepA, voffA);
            PG8_WAIT_V(8); PG8_WAIT_L(0); PG8_BAR; PG8_MMA(0, 0, At, B0); PG8_MMA(0, 1, At, B1); PG8_BAR; PG8_SCHED;
            PG8_LDA(At, 1, 1); PG8_STAGE(PG8_SB(1, 0), b3, voffB); PG8_STAGE(PG8_SB(1, 1), b3 + hstepB, voffB); PG8_STAGE(PG8_SA(1, 0), a3, voffA);
            PG8_WAIT_V(8); PG8_WAIT_L(0); PG8_BAR; PG8_MMA(1, 0, At, B0); PG8_MMA(1, 1, At, B1); PG8_BAR; PG8_SCHED;
            } else {
            PG8_LDB(B0, 0, 0); PG8_SCHED; PG8_LDA(At, 0, 0); PG8_STAGE(PG8_SA(1, 1), a1 + hstepA, voffA);
            PG8_WAIT_L(8); PG8_BAR; PG8_WAIT_L(0); PG8_MMA(0, 0, At, B0); PG8_BAR; PG8_SCHED;
            PG8_LDB(B1, 0, 1); PG8_STAGE(PG8_SB(0, 0), b2, voffB);
            PG8_BAR; PG8_WAIT_L(0); PG8_MMA(0, 1, At, B1); PG8_BAR;
            PG8_LDA(At, 0, 1); PG8_STAGE(PG8_SA(0, 0), a2, voffA);
            PG8_BAR; PG8_WAIT_L(0); PG8_MMA(1, 0, At, B0); PG8_BAR; PG8_SCHED;
            PG8_STAGE(PG8_SB(0, 1), b2 + hstepB, voffB);
            PG8_WAIT_V(6); PG8_BAR; PG8_MMA(1, 1, At, B1); PG8_BAR;
            PG8_LDB(B0, 1, 0); PG8_SCHED; PG8_LDA(At, 1, 0); PG8_STAGE(PG8_SA(0, 1), a2 + hstepA, voffA);
            PG8_WAIT_L(8); PG8_BAR; PG8_WAIT_L(0); PG8_MMA(0, 0, At, B0); PG8_BAR; PG8_SCHED;
            PG8_LDB(B1, 1, 1); PG8_STAGE(PG8_SB(1, 0), b3, voffB);
            PG8_BAR; PG8_WAIT_L(0); PG8_MMA(0, 1, At, B1); PG8_BAR;
            PG8_LDA(At, 1, 1); PG8_STAGE(PG8_SA(1, 0), a3, voffA);
            PG8_BAR; PG8_WAIT_L(0); PG8_MMA(1, 0, At, B0); PG8_BAR; PG8_SCHED;
            PG8_STAGE(PG8_SB(1, 1), b3 + hstepB, voffB);
            PG8_WAIT_V(6); PG8_BAR; PG8_MMA(1, 1, At, B1); PG8_BAR;
            }
        }
        if constexpr (ALIGN_EPI) { if (wr == 0) PG8_BAR; }
        if constexpr (!Epi::AFTER_DRAIN) { E(acc, cur, wr, wc, fr, fq); S.done(cur); }
        if (!has_next) break;
#pragma unroll
        for (int a = 0; a < 2; ++a)
#pragma unroll
            for (int b = 0; b < 2; ++b)
#pragma unroll
                for (int m = 0; m < 4; ++m)
#pragma unroll
                    for (int n = 0; n < 2; ++n) acc[a][b][m][n] = (f32x4){0.f, 0.f, 0.f, 0.f};
        cur = nxt; cA = nA; cB = nB; ++ui;
        if constexpr (ALIGN_EPI) { if (wr == 1) PG8_BAR; }
    }
    PG8_WAIT_V(0);
    if constexpr (!ALIGN_EPI) { if (wr == 0) PG8_BAR; }
    PG8_BAR;
#undef PG8_SA
#undef PG8_SB
#undef PG8_STAGE
#undef PG8_LDA
#undef PG8_LDB
#undef PG8_MMA
#undef PG8_WAIT_V
#undef PG8_WAIT_L
#undef PG8_BAR
#undef PG8_SCHED
}
}

namespace att {
constexpr int VOFF = 26624, BUFB = 43008, NPIECE = 42;
constexpr int KP_DA = 144, KCOMP_DA = 64 * KP_DA;
constexpr int KNP = 272, KR_OFF = 64 * KNP, KRP = 144;
struct Tensors { const bf16_t* PROJ; const bf16_t* KD; const bf16_t* VD; const bf16_t* QM; const bf16_t* KN; const bf16_t* VM; const bf16_t* KR; bf16_t* MIX; const float* gsub; const unsigned* kmax; };
__device__ __forceinline__ float swap_max(float v) { auto rr = __builtin_amdgcn_permlane32_swap(__float_as_uint(v), __float_as_uint(v), false, false); return fmaxf(__uint_as_float(rr[0]), __uint_as_float(rr[1])); }
__device__ __forceinline__ float swap_sum(float v) { auto rr = __builtin_amdgcn_permlane32_swap(__float_as_uint(v), __float_as_uint(v), false, false); return __uint_as_float(rr[0]) + __uint_as_float(rr[1]); }
__device__ __forceinline__ unsigned off_b(unsigned row, unsigned ch) { return 256u * row + 16u * (ch ^ (((row & 3) << 2) | ((row >> 2) & 3))); }
__device__ __forceinline__ unsigned tr_read_addr(unsigned lane, unsigned c, unsigned ks, unsigned t) {
    const unsigned h = lane >> 5, blk = (lane >> 4) & 1, q = (lane & 15) >> 2, p = lane & 3;
    return off_b(16 * ks + 8 * h + 4 * t + q, 4 * c + 2 * blk + (p >> 1)) + 8 * (p & 1);
}
__device__ __forceinline__ bf16x8 pack_p(const f32x16& p, int o) {
    u32x4 w; w.x = pg8::cvt_pk_bf16(p[o + 0], p[o + 1]); w.y = pg8::cvt_pk_bf16(p[o + 2], p[o + 3]); w.z = pg8::cvt_pk_bf16(p[o + 4], p[o + 5]); w.w = pg8::cvt_pk_bf16(p[o + 6], p[o + 7]);
    return __builtin_bit_cast(bf16x8, w);
}

__device__ __forceinline__ void glds16(const void* gsrc, unsigned lds_dst) { unsigned keep;
    asm volatile("s_mov_b32 %0, m0\n\ts_mov_b32 m0, %2\n\ts_nop 0\n\tglobal_load_lds_dwordx4 %1, off\n\ts_mov_b32 m0, %0" : "=&s"(keep) : "v"(gsrc), "s"(lds_dst) : "memory"); }
#define ATT_WAITBAR(N) asm volatile("s_waitcnt vmcnt(" #N ") lgkmcnt(0)\n\ts_barrier" ::: "memory")
__device__ __forceinline__ float mx3(float a, float b, float c) { return __builtin_fmaxf(__builtin_fmaxf(a, b), c); }
template <bool DA>
__device__ __forceinline__ void attn_unit(LAS unsigned char* lds, const Tensors& T, int b, int h, int u, float lam) {
    int tid_ = threadIdx.x; asm volatile("" : "+v"(tid_));
    const int tid = tid_, lane = tid & 63, q32 = lane & 31, hi = lane >> 5;
    const int wid = __builtin_amdgcn_readfirstlane(tid >> 6);
    const int comp = DA ? (wid >> 2) : 0, wq = DA ? (wid & 3) : wid;
    unsigned voff[6];
#pragma unroll
    for (int i = 0; i < 6; ++i) {
        const unsigned pi = wid + 8 * i, o = pi * 1024 + lane * 16; unsigned v = 0;
        if (o < (unsigned)VOFF) {
            if (DA) { const unsigned cp = o / KCOMP_DA, rem = o - cp * KCOMP_DA, key = rem / KP_DA; unsigned cc = (rem - key * KP_DA) >> 4; if (cc == 8) cc = 0; v = (key & 63) * 256 + (cp & 1) * 128 + cc * 16; }
            else if (o < (unsigned)KR_OFF) { const unsigned key = o / KNP; unsigned cc = (o - key * KNP) >> 4; if (cc == 16) cc = 0; v = key * 256 + cc * 16; }
            else { const unsigned o2 = o - KR_OFF, key = o2 / KRP; unsigned cc = (o2 - key * KRP) >> 4; if (cc == 8) cc = 0; v = (key & 63) * 128 + cc * 16; }
        } else {
            const unsigned ov = o - VOFF, img = (ov >> 13) & 1, slot = (ov & 8191) >> 4, rho = slot >> 4, chp = slot & 15;
            const unsigned ch = chp ^ (((rho & 3) << 2) | ((rho >> 2) & 3)), kk = (rho & ~12u) | ((rho & 4) << 1) | ((rho & 8) >> 1), key = 32 * img + kk;
            v = key * 256 + ch * 16;
        }
        voff[i] = v;
    }
    const unsigned lds0 = (unsigned)(size_t)lds;
    const int npiece = DA ? (wid < 2 ? 5 : 4) : (wid < 2 ? 6 : 5);
    constexpr int QPU = DA ? 128 : 256, CPU = QPU / 64;
    const int NT = CPU * u + CPU + 1;
    const int tmax = CPU * u + (wq >> 1) + 1;
    auto issue = [&](int tt, int bufoff) {
        const size_t row0 = (tt == 0) ? (size_t)MX : (size_t)b * SEQ + (size_t)(tt - 1) * 64;
        const char *pK, *pK2, *pV;
        const size_t hrow = ((size_t)h * MALL + row0) * 256;
        if (DA) { pK = (const char*)T.KD + hrow; pK2 = pK; pV = (const char*)T.VD + hrow; }
        else { pK = (const char*)T.KN + hrow; pK2 = (const char*)T.KR + row0 * 128; pV = (const char*)T.VM + hrow; }
#pragma unroll
        for (int i = 0; i < 6; ++i) {
            const int pi = wid + 8 * i;
            if (pi >= NPIECE) continue;
            if (DA && pi >= 18 && pi < 26) continue;
            const char* base = (pi >= 26) ? pV : ((!DA && pi >= 17) ? pK2 : pK);
            glds16(base + voff[i], (unsigned)__builtin_amdgcn_readfirstlane((int)(lds0 + bufoff + pi * 1024)));
        }
    };
    issue(NT - 1, 0); issue(NT - 2, BUFB);
    const int qx = u * QPU + wq * 32 + q32;
    const size_t qrow = (size_t)b * SEQ + qx;
    constexpr int NQF = DA ? 4 : 12;
    bf16x8 qf[NQF];
    if (DA) { const bf16_t* qp = T.PROJ + qrow * PPITCH + 128 * h + 64 * comp + 8 * hi;
#pragma unroll
        for (int s = 0; s < 4; ++s) qf[s] = *(const bf16x8*)(qp + 16 * s); }
    else { const bf16_t* qp = T.QM + qrow * 768 + 192 * h + 8 * hi;
#pragma unroll
        for (int s = 0; s < 12; ++s) qf[s] = *(const bf16x8*)(qp + 16 * s); }
#pragma unroll
    for (int s = 0; s < NQF; ++s) asm volatile("" : "+v"(qf[s]));
    float qbound = 0.f;
    LAS unsigned* vote = (LAS unsigned*)(lds + 131072) + 8;
    if (DA) {
        float ss = 0.f;
#pragma unroll
        for (int s = 0; s < 4; ++s)
#pragma unroll
            for (int e = 0; e < 8; ++e) { const float v = __uint_as_float(((unsigned)(unsigned short)qf[s][e]) << 16); ss += v * v; }
        ss = swap_sum(ss);
        const float km = __uint_as_float(__hip_atomic_load(T.kmax + 2 * (2 * h + comp), __ATOMIC_RELAXED, __HIP_MEMORY_SCOPE_AGENT)) + __uint_as_float(__hip_atomic_load(T.kmax + 2 * (2 * h + comp) + 1, __ATOMIC_RELAXED, __HIP_MEMORY_SCOPE_AGENT));
        qbound = sqrtf(ss * km) * 1.01f;
        if (tid < 3) vote[tid] = 0u;
    }
    bool wdone = false; int vi = 0;
    f32x16 O[4]; float mrun = -1e30f, lrun = 0.f;
#pragma unroll
    for (int cc = 0; cc < 4; ++cc)
#pragma unroll
        for (int r = 0; r < 16; ++r) O[cc][r] = 0.f;
    const float slope2 = DA ? exp2f(-2.0f * (float)(h + 1)) * LOG2E : 0.f;
    const float H64 = 64.0f * slope2, H32 = 32.0f * slope2;
    f32x16 cvec;
#pragma unroll
    for (int r = 0; r < 16; ++r) cvec[r] = DA ? slope2 * (float)((r & 3) + 8 * (r >> 2) + 4 * hi) : 0.f;
    unsigned vad[4][2];
#pragma unroll
    for (int cc = 0; cc < 4; ++cc)
#pragma unroll
        for (int t = 0; t < 2; ++t) vad[cc][t] = tr_read_addr(lane, cc, 0, t);
    if (npiece == 6) ATT_WAITBAR(6); else if (npiece == 5) ATT_WAITBAR(5); else ATT_WAITBAR(4);

    int bo0 = 0, bo1 = BUFB, bo2 = 2 * BUFB;
    for (int tt = NT - 1; tt >= 0; --tt) {
        if (tt >= 2) issue(tt - 2, bo2);
        if (tt <= tmax) {
            LAS unsigned char* kb = lds + bo0;
            LAS unsigned char* vb = kb + VOFF;
            f32x16 p0, p1;
#define ATT_VFRAG(dst, cc_, kap_) do { const v4i16_t lo_ = __builtin_amdgcn_ds_read_tr16_b64_v4i16((LAS v4i16_t*)(vb + vad[cc_][0] + ((kap_) & 1) * 4096 + ((kap_) >> 1) * 8192)); \
                const v4i16_t hh_ = __builtin_amdgcn_ds_read_tr16_b64_v4i16((LAS v4i16_t*)(vb + vad[cc_][1] + ((kap_) & 1) * 4096 + ((kap_) >> 1) * 8192)); \
                dst = (bf16x8){lo_[0], lo_[1], lo_[2], lo_[3], hh_[0], hh_[1], hh_[2], hh_[3]}; } while (0)
#define ATT_SB() __builtin_amdgcn_sched_barrier(0)
            bf16x8 va[4], vbf[4];
            if (DA) {
                mrun += H64;
                LAS unsigned char* kp = kb + comp * KCOMP_DA + q32 * KP_DA + hi * 16;
                bf16x8 kf[8];
#pragma unroll
                for (int s = 0; s < 4; ++s) { kf[2 * s] = *(const LAS bf16x8*)(kp + 32 * s); kf[2 * s + 1] = *(const LAS bf16x8*)(kp + 32 * KP_DA + 32 * s); }
                ATT_SB();
                p0 = __builtin_amdgcn_mfma_f32_32x32x16_bf16(kf[0], qf[0], cvec, 0, 0, 0); p1 = __builtin_amdgcn_mfma_f32_32x32x16_bf16(kf[1], qf[0], cvec, 0, 0, 0);
#pragma unroll
                for (int s = 1; s < 4; ++s) { p0 = __builtin_amdgcn_mfma_f32_32x32x16_bf16(kf[2 * s], qf[s], p0, 0, 0, 0); p1 = __builtin_amdgcn_mfma_f32_32x32x16_bf16(kf[2 * s + 1], qf[s], p1, 0, 0, 0); }
                ATT_SB();
            } else {
                const f32x16 z16 = {0.f, 0.f, 0.f, 0.f, 0.f, 0.f, 0.f, 0.f, 0.f, 0.f, 0.f, 0.f, 0.f, 0.f, 0.f, 0.f};
                LAS unsigned char* kp = kb + q32 * KNP + hi * 16;
                LAS unsigned char* kp2 = kb + KR_OFF + q32 * KRP + hi * 16;
                bf16x8 kA[4], kB[4];
#define ATT_KADDR(s_) ((s_) < 8 ? kp + 32 * (s_) : kp2 + 32 * ((s_) - 8))
#define ATT_KLOAD(dst, j_) do { dst[0] = *(const LAS bf16x8*)(ATT_KADDR(2 * (j_))); dst[1] = *(const LAS bf16x8*)(ATT_KADDR(2 * (j_)) + ((j_) < 4 ? 32 * KNP : 32 * KRP)); \
                dst[2] = *(const LAS bf16x8*)(ATT_KADDR(2 * (j_) + 1)); dst[3] = *(const LAS bf16x8*)(ATT_KADDR(2 * (j_) + 1) + ((j_) < 4 ? 32 * KNP : 32 * KRP)); } while (0)
#define ATT_KMM(src, j_) do { p0 = __builtin_amdgcn_mfma_f32_32x32x16_bf16(src[0], qf[2 * (j_)], p0, 0, 0, 0); p1 = __builtin_amdgcn_mfma_f32_32x32x16_bf16(src[1], qf[2 * (j_)], p1, 0, 0, 0); \
                p0 = __builtin_amdgcn_mfma_f32_32x32x16_bf16(src[2], qf[2 * (j_) + 1], p0, 0, 0, 0); p1 = __builtin_amdgcn_mfma_f32_32x32x16_bf16(src[3], qf[2 * (j_) + 1], p1, 0, 0, 0); } while (0)
                ATT_KLOAD(kA, 0); ATT_KLOAD(kB, 1); ATT_SB();
                p0 = z16; p1 = z16;
                ATT_KMM(kA, 0); ATT_SB(); ATT_KLOAD(kA, 2); ATT_SB();
                ATT_KMM(kB, 1); ATT_SB(); ATT_KLOAD(kB, 3); ATT_SB();
                ATT_KMM(kA, 2); ATT_SB(); ATT_KLOAD(kA, 4); ATT_SB();
                ATT_KMM(kB, 3); ATT_SB(); ATT_KLOAD(kB, 5); ATT_SB();
                ATT_KMM(kA, 4); ATT_SB(); ATT_KMM(kB, 5); ATT_SB();
            }
            float off0 = 0.f, off1 = 0.f;
            if (DA) {
                off1 = H32;
                if (tt == 0) off0 = 48.0f * slope2;
                if (tt == tmax) {
                    const float qoff = (float)(qx - 64 * (tt - 1)), dq = qoff - (float)(4 * hi);
#pragma unroll
                    for (int r = 0; r < 16; ++r) { const float cr = (float)((r & 3) + 8 * (r >> 2));
                        p0[r] = (p0[r] - cvec[r]) - slope2 * fabsf(dq - cr); p1[r] = (p1[r] - cvec[r]) - slope2 * fabsf(dq - 32.0f - cr); }
                    off0 = slope2 * qoff; off1 = off0;
                }
            }
            if (tt == 0) {
#pragma unroll
                for (int r = 0; r < 16; ++r) { if (r >= 8) p0[r] = -1e30f; p1[r] = -1e30f; }
            }
            float ra = mx3(p0[0], p0[1], p0[2]), rb = mx3(p1[0], p1[1], p1[2]);
            ra = mx3(ra, p0[3], p0[4]); rb = mx3(rb, p1[3], p1[4]);
#pragma unroll
            for (int r = 5; r < 15; r += 2) { ra = mx3(ra, p0[r], p0[r + 1]); rb = mx3(rb, p1[r], p1[r + 1]); }
            ra = fmaxf(ra, p0[15]); rb = fmaxf(rb, p1[15]);
            const float rm = swap_max(fmaxf(ra + off0, rb + off1));
            const bool skip = DA && __all(rm - mrun < -40.0f);
            if (!skip) {
                const float mn = fmaxf(mrun, rm), alpha = __builtin_amdgcn_exp2f(mrun - mn);
                mrun = mn;
                const float m0 = mn - off0, m1 = mn - off1;
                float sum = 0.f;
#pragma unroll
                for (int r = 0; r < 16; ++r) { p0[r] = __builtin_amdgcn_exp2f(p0[r] - m0); p1[r] = __builtin_amdgcn_exp2f(p1[r] - m1); sum += p0[r] + p1[r]; }
                ATT_SB();
#pragma unroll
                for (int cc = 0; cc < 4; ++cc) ATT_VFRAG(va[cc], cc, 0);
                ATT_SB();
                lrun = lrun * alpha + sum;
                if (__any(alpha != 1.0f)) {
#pragma unroll
                    for (int cc = 0; cc < 4; ++cc)
#pragma unroll
                        for (int r = 0; r < 16; ++r) O[cc][r] *= alpha;
                }
                bf16x8 pf[4]; pf[0] = pack_p(p0, 0); pf[1] = pack_p(p0, 8); pf[2] = pack_p(p1, 0); pf[3] = pack_p(p1, 8);
#define ATT_PVMM(src, kap_) do { _Pragma("unroll") for (int cc = 0; cc < 4; ++cc) O[cc] = __builtin_amdgcn_mfma_f32_32x32x16_bf16(src[cc], pf[kap_], O[cc], 0, 0, 0); } while (0)
#define ATT_PVLD(dst, kap_) do { _Pragma("unroll") for (int cc = 0; cc < 4; ++cc) ATT_VFRAG(dst[cc], cc, kap_); } while (0)
                ATT_SB(); ATT_PVLD(vbf, 1); ATT_SB();
                ATT_PVMM(va, 0); ATT_SB(); ATT_PVLD(va, 2); ATT_SB();
                ATT_PVMM(vbf, 1); ATT_SB(); ATT_PVLD(vbf, 3); ATT_SB();
                ATT_PVMM(va, 2); ATT_SB(); ATT_PVMM(vbf, 3); ATT_SB();
            }
        }
        if (DA) {
            if (tt <= tmax && !wdone) wdone = __all(qbound + 63.0f * slope2 - (mrun + H64) < -40.0f);
            const int vn = vi == 2 ? 0 : vi + 1;
            if (tid == 0) vote[vn] = 0u;
            if (wdone && lane == 0) __hip_atomic_fetch_add(vote + vi, 1u, __ATOMIC_RELAXED, __HIP_MEMORY_SCOPE_WORKGROUP);
        }
        if (tt >= 2) { if (npiece == 6) ATT_WAITBAR(6); else if (npiece == 5) ATT_WAITBAR(5); else ATT_WAITBAR(4); }
        else ATT_WAITBAR(0);
        { const int t_ = bo0; bo0 = bo1; bo1 = bo2; bo2 = t_; }
        if (DA) {
            const unsigned nv = *(volatile LAS unsigned*)(vote + vi);
            vi = vi == 2 ? 0 : vi + 1;
            if (nv == 8u && tt > 0) { ATT_WAITBAR(0); break; }
        }
    }
    if (DA) {
        LAS float* xch = (LAS float*)lds + (size_t)wq * 64 * 64 + lane;
        const float i1 = (comp ? lam : 1.0f) / swap_sum(lrun);
        if (comp == 1) {
#pragma unroll
            for (int cc = 0; cc < 4; ++cc)
#pragma unroll
                for (int r = 0; r < 16; ++r) xch[(cc * 16 + r) * 64] = O[cc][r] * i1;
        }
        __syncthreads();
        if (comp == 0) {
            float ss = 0.f;
#pragma unroll
            for (int cc = 0; cc < 4; ++cc)
#pragma unroll
                for (int r = 0; r < 16; ++r) { const float o = O[cc][r] * i1 - xch[(cc * 16 + r) * 64]; O[cc][r] = o; ss += o * o; if ((r & 7) == 7) asm volatile("" ::: "memory"); }
            ss = swap_sum(ss);
            const float rn = rsqrtf(ss * (1.0f / 128.0f) + EPS) * 0.8f;
            bf16_t* op = T.MIX + qrow * 1024 + 128 * h + 4 * hi;
#pragma unroll
            for (int cc = 0; cc < 4; ++cc)
#pragma unroll
                for (int g = 0; g < 4; ++g) { const f32x4 gs = *(const f32x4*)(T.gsub + 32 * cc + 8 * g + 4 * hi);
                    u32x2 w; w.x = pg8::cvt_pk_bf16(O[cc][4 * g] * rn * gs[0], O[cc][4 * g + 1] * rn * gs[1]); w.y = pg8::cvt_pk_bf16(O[cc][4 * g + 2] * rn * gs[2], O[cc][4 * g + 3] * rn * gs[3]);
                    *(u32x2*)(op + 32 * cc + 8 * g) = w; asm volatile("" ::: "memory"); }
        }
        __syncthreads();
    } else {
        const float i1 = 1.0f / swap_sum(lrun);
        bf16_t* op = T.MIX + qrow * 1024 + 512 + 128 * h + 4 * hi;
#pragma unroll
        for (int cc = 0; cc < 4; ++cc)
#pragma unroll
            for (int g = 0; g < 4; ++g) { u32x2 w; w.x = pg8::cvt_pk_bf16(O[cc][4 * g] * i1, O[cc][4 * g + 1] * i1); w.y = pg8::cvt_pk_bf16(O[cc][4 * g + 2] * i1, O[cc][4 * g + 3] * i1);
                *(u32x2*)(op + 32 * cc + 8 * g) = w; }
    }
}
}

struct Params { const float* in[19]; float* out; unsigned char* ws; float inv_freq[32]; };
constexpr int LDS_BYTES = 131072 + 512;

__device__ __forceinline__ float wave_sum(float v) {
#pragma unroll
    for (int o = 1; o < 64; o <<= 1) v += __shfl_xor(v, o);
    return v;
}
__device__ __forceinline__ int src_col(int kind, int n) {
    if (kind == 0) { if (n < 1920) return n; if (n < 1984) { const int j = n - 1920; return 1920 + (j & 1) * 32 + (j >> 1); } return -1; }
    if (kind == 1) { const int hh = n / 192, d = n % 192; if (d < 128) return n; const int j = d - 128; return 192 * hh + 128 + (j & 1) * 32 + (j >> 1); }
    return n;
}
__device__ __forceinline__ void transpose_item(const float* W, int K, int N, bf16_t* WT, int kind, const float* gain, LAS float* scr, int item, int nblk, int lane) {
    const int kb = item / nblk, nb = item % nblk, k0 = 64 * kb, n0 = 32 * nb;
    const int src = src_col(kind, n0 + (lane & 31));
    const float cs = (kind == 0 && n0 < 512) ? C2_DA : 1.0f;
#pragma unroll 8
    for (int i = 0; i < 32; ++i) { const int kk = 2 * i + (lane >> 5); float v = 0.f; if (src >= 0) v = W[(size_t)(k0 + kk) * N + src]; if (gain) v *= gain[k0 + kk]; scr[kk * 33 + (lane & 31)] = v * cs; }
    asm volatile("s_waitcnt lgkmcnt(0)" ::: "memory");
    const int c = lane & 7;
#pragma unroll
    for (int j = 0; j < 4; ++j) { const int n = (lane >> 3) + 8 * j; const LAS float* s = scr + (8 * c) * 33 + n;
        u32x4 o; o.x = pg8::cvt_pk_bf16(s[0 * 33], s[1 * 33]); o.y = pg8::cvt_pk_bf16(s[2 * 33], s[3 * 33]); o.z = pg8::cvt_pk_bf16(s[4 * 33], s[5 * 33]); o.w = pg8::cvt_pk_bf16(s[6 * 33], s[7 * 33]);
        *(u32x4*)(WT + (size_t)(n0 + n) * K + k0 + 8 * c) = o; }
    asm volatile("s_waitcnt lgkmcnt(0)" ::: "memory");
}

__global__ void __launch_bounds__(512, 2) fwd_megakernel(Params P) {
    extern __shared__ __attribute__((aligned(16))) unsigned char lds_raw[];
    LAS unsigned char* lds = (LAS unsigned char*)lds_raw;
    cg::grid_group grid = cg::this_grid();
    const int tid = threadIdx.x, lane = tid & 63, wave = __builtin_amdgcn_readfirstlane(tid >> 6);
    const int G = gridDim.x, bx = blockIdx.x;
    int vcu = (G % 8 == 0) ? (bx % 8) * (G / 8) + bx / 8 : bx;
    int cid = bx;
#define XIN (P.in[0])
#define RQ ((float*)(P.ws + WS_STAT))
#define RKV (RQ + MALL)
#define SS1 (RQ + 2 * MALL)
#define SS2 (RQ + 3 * MALL)
#define TAB ((float*)(P.ws + WS_TAB))
#define WIN ((bf16_t*)(P.ws + WS_WIN))
#define WQ ((bf16_t*)(P.ws + WS_WQ))
#define WKV ((bf16_t*)(P.ws + WS_WKV))
#define WO ((bf16_t*)(P.ws + WS_WO))
#define W1 ((bf16_t*)(P.ws + WS_W1))
#define W2 ((bf16_t*)(P.ws + WS_W2))
#define U ((bf16_t*)(P.ws + WS_U))
#define MIX ((bf16_t*)(P.ws + WS_MIX))
#define MIXO ((bf16_t*)(P.ws + WS_MIXO))
#define PROJ ((bf16_t*)(P.ws + WS_PROJ))
#define KD ((bf16_t*)(P.ws + WS_KD))
#define VD ((bf16_t*)(P.ws + WS_VD))
#define QM ((bf16_t*)(P.ws + WS_QM))
#define KN ((bf16_t*)(P.ws + WS_KN))
#define VM ((bf16_t*)(P.ws + WS_VM))
#define KR ((bf16_t*)(P.ws + WS_KR))
#define HB ((bf16_t*)(P.ws + WS_H))
#define FB MIX
    const int NGW = G * 8;
    int gw = vcu * 8 + wave;
    unsigned* ctl = (unsigned*)(P.ws + WS_CTL);
    LAS unsigned* misc = (LAS unsigned*)(lds + 131072);
    const unsigned xcc = (unsigned)__builtin_amdgcn_s_getreg((3 << 11) | 20) & 7u;
    if (tid == 0) misc[0] = __hip_atomic_fetch_add(ctl + 16 * xcc, 1u, __ATOMIC_RELAXED, __HIP_MEMORY_SCOPE_AGENT);

#if (PH >> 0) & 1
    {
        LAS float* scr = (LAS float*)(lds + wave * 16384);
        constexpr int I_IN = 16 * 64, I_Q = 4 * 24, I_KV = 2 * 32, I_O = 16 * 32, I_1 = 16 * 128, I_2 = 64 * 32;
        constexpr int NITEMS = I_IN + I_Q + I_KV + I_O + I_1 + I_2;
        for (int it = gw; it < NITEMS; it += NGW) {
            int r = it;
            if (r < I_IN) { transpose_item(P.in[3], 1024, 1984, WIN, 0, nullptr, scr, r, 64, lane); continue; } r -= I_IN;
            if (r < I_Q) { transpose_item(P.in[10], 256, 768, WQ, 1, P.in[9], scr, r, 24, lane); continue; } r -= I_Q;
            if (r < I_KV) { transpose_item(P.in[12], 128, 1024, WKV, 2, P.in[11], scr, r, 32, lane); continue; } r -= I_KV;
            if (r < I_O) { transpose_item(P.in[13], 1024, 1024, WO, 2, nullptr, scr, r, 32, lane); continue; } r -= I_O;
            if (r < I_1) { transpose_item(P.in[16], 1024, 4096, W1, 2, nullptr, scr, r, 128, lane); continue; } r -= I_1;
            transpose_item(P.in[17], 4096, 1024, W2, 2, nullptr, scr, r, 32, lane);
        }
        f32x4 gp[4];
#pragma unroll
        for (int j = 0; j < 4; ++j) gp[j] = *(const f32x4*)(P.in[2] + 4 * lane + 256 * j);
        for (int m = gw; m < MALL; m += NGW) {
            unsigned long long* o8 = (unsigned long long*)(U + (size_t)m * 1024) + lane;
            if (m >= MX + N_META) {
#pragma unroll
                for (int j = 0; j < 4; ++j) o8[64 * j] = 0ull;
                continue; }
            const float* src = (m < MX) ? XIN + (size_t)m * 1024 : P.in[1] + (size_t)(m - MX) * 1024;
            f32x4 v[4]; float s = 0.f;
#pragma unroll
            for (int j = 0; j < 4; ++j) { v[j] = *(const f32x4*)(src + 4 * lane + 256 * j); s += (v[j][0] * v[j][0] + v[j][1] * v[j][1]) + (v[j][2] * v[j][2] + v[j][3] * v[j][3]); }
            const float rs = rsqrtf(wave_sum(s) * (1.0f / 1024.0f) + EPS);
#pragma unroll
            for (int j = 0; j < 4; ++j) { const f32x4 y = v[j] * rs * gp[j];
                o8[64 * j] = (unsigned long long)pg8::cvt_pk_bf16(y[0], y[1]) | ((unsigned long long)pg8::cvt_pk_bf16(y[2], y[3]) << 32); }
        }
        const int gt = vcu * 512 + tid, NGT = G * 512;
        for (int i = gt; i < 4 * MALL; i += NGT) RQ[i] = 0.f;
        for (int i = gt; i < LTOT * 32; i += NGT) {
            const int pos = i >> 5, fi = i & 31;
            const float ang = (float)pos * P.inv_freq[fi];
            const double a = (double)ang; const double k = rint(a * 0.6366197723675814); const double r = fma(-k, 1.5707963267948966, a) - k * 6.123233995736766e-17;
            const double r2 = r * r;
            double sn = r * (1.0 + r2 * (-1.0 / 6 + r2 * (1.0 / 120 + r2 * (-1.0 / 5040 + r2 * (1.0 / 362880 + r2 * (-1.0 / 39916800 + r2 * (1.0 / 6227020800.0)))))));
            double cs = 1.0 + r2 * (-0.5 + r2 * (1.0 / 24 + r2 * (-1.0 / 720 + r2 * (1.0 / 40320 + r2 * (-1.0 / 3628800 + r2 * (1.0 / 479001600.0))))));
            const int qd = ((int)k) & 3;
            double c_, s_;
            if (qd == 0) { c_ = cs; s_ = sn; } else if (qd == 1) { c_ = -sn; s_ = cs; } else if (qd == 2) { c_ = -cs; s_ = -sn; } else { c_ = sn; s_ = -cs; }
            TAB[2 * i] = (float)c_; TAB[2 * i + 1] = (float)s_;
        }
    }
#endif
    grid.sync();
    if (tid == 0) { unsigned base = 0, n[8];
#pragma unroll
        for (int j = 0; j < 8; ++j) n[j] = __hip_atomic_load(ctl + 16 * j, __ATOMIC_RELAXED, __HIP_MEMORY_SCOPE_AGENT);
#pragma unroll
        for (int j = 0; j < 8; ++j) if ((unsigned)j < xcc) base += n[j];
        misc[1] = base + misc[0]; }
    __syncthreads();
    if (G == 256) { vcu = __builtin_amdgcn_readfirstlane((int)misc[1]); cid = (vcu & 31) * 8 + (vcu >> 5); gw = vcu * 8 + wave; }

#if (PH >> 1) & 1
    {
        pg8::Gemm g{U, WIN, MALL, NPROJ, 1024, 1024}; pg8::StaticOrder S; S.init(MALL, NPROJ, G, cid);
        pg8::EpiIn E{PROJ, KD, VD, KR, RQ, RKV, TAB, ctl + 128};
        pg8::gemm_phase<pg8::EpiIn, pg8::StaticOrder, true, true>(lds, g, S, E);
    }
#endif
    grid.sync();

#if (PH >> 2) & 1
    {
        pg8::Gemm g{PROJ + 512, WQ, MX, 768, 256, PPITCH}; pg8::StaticOrder S; S.init(MX, 768, G, cid);
        pg8::EpiQ E{QM, RQ, TAB};
        pg8::gemm_phase<pg8::EpiQ, pg8::StaticOrder, true, true>(lds, g, S, E);
    }
    {
        pg8::Gemm g{PROJ + 768, WKV, MALL, 1024, 128, PPITCH}; pg8::StaticOrder S; S.init(MALL, 1024, G, (cid + 128) % G);
        pg8::EpiKV E{KN, VM, RKV};
        pg8::gemm_phase<pg8::EpiKV, pg8::StaticOrder, true, true>(lds, g, S, E);
    }
#endif
    grid.sync();

#if (PH >> 3) & 1
    {
        float a = P.in[4][lane] * P.in[5][lane], c = P.in[6][lane] * P.in[7][lane];
        a = wave_sum(a); c = wave_sum(c);
        const float lam = expf(a) - expf(c) + 0.2f;
        const att::Tensors T{PROJ, KD, VD, QM, KN, VM, KR, MIX, P.in[8], ctl + 128};
        if (G == 256) {
            const int b = vcu >> 5, i = vcu & 31;
            for (int j = 0; j < 6; ++j) {
                if (j == 2) att::attn_unit<false>(lds, T, b, i < 16 ? 0 : 1, i & 15, 0.f);
                else if (j == 5) att::attn_unit<false>(lds, T, b, i < 16 ? 2 : 3, 15 - (i & 15), 0.f);
                else { const int hh = j < 2 ? j : j - 1; att::attn_unit<true>(lds, T, b, hh, (hh == 0 || hh == 3) ? i : 31 - i, lam); }
            }
        }
    }
#endif
    grid.sync();

#if (PH >> 4) & 1
    {
        pg8::Gemm g{MIX, WO, MX, 1024, 1024, 1024}; pg8::StaticOrder S; S.init(MX, 1024, G, cid);
        pg8::EpiSS E{MIXO, 1024, SS1};
        pg8::gemm_phase<pg8::EpiSS, pg8::StaticOrder, true, true>(lds, g, S, E);
    }
#endif
    grid.sync();

#if (PH >> 5) & 1
    {
        f32x4 g1[4], g2[4];
#pragma unroll
        for (int j = 0; j < 4; ++j) { g1[j] = *(const f32x4*)(P.in[14] + 4 * lane + 256 * j); g2[j] = *(const f32x4*)(P.in[15] + 4 * lane + 256 * j); }
        for (int m = gw; m < MX; m += NGW) {
            const float r1 = rsqrtf(SS1[m] * (1.0f / 1024.0f) + EPS);
            const unsigned long long* mi = (const unsigned long long*)(MIXO + (size_t)m * 1024) + lane;
            f32x4 hv[4]; float s = 0.f;
#pragma unroll
            for (int j = 0; j < 4; ++j) { const f32x4 xv = *(const f32x4*)(XIN + (size_t)m * 1024 + 4 * lane + 256 * j); const unsigned long long w = mi[64 * j];
                f32x4 mv; mv[0] = __uint_as_float((unsigned)(w & 0xffffu) << 16); mv[1] = __uint_as_float((unsigned)w & 0xffff0000u); mv[2] = __uint_as_float((unsigned)((w >> 32) & 0xffffu) << 16); mv[3] = __uint_as_float((unsigned)(w >> 32) & 0xffff0000u);
                hv[j] = xv + mv * r1 * g1[j]; s += (hv[j][0] * hv[j][0] + hv[j][1] * hv[j][1]) + (hv[j][2] * hv[j][2] + hv[j][3] * hv[j][3]);
                *(f32x4*)(P.out + (size_t)m * 1024 + 4 * lane + 256 * j) = hv[j]; }
            const float rs = rsqrtf(wave_sum(s) * (1.0f / 1024.0f) + EPS);
            unsigned long long* o8 = (unsigned long long*)(U + (size_t)m * 1024) + lane;
#pragma unroll
            for (int j = 0; j < 4; ++j) { const f32x4 y = hv[j] * rs * g2[j];
                o8[64 * j] = (unsigned long long)pg8::cvt_pk_bf16(y[0], y[1]) | ((unsigned long long)pg8::cvt_pk_bf16(y[2], y[3]) << 32); }
        }
    }
#endif
    grid.sync();

#if (PH >> 6) & 1
    {
        pg8::Gemm g{U, W1, MX, D_FF, 1024, 1024}; pg8::StaticOrder S; S.init(MX, D_FF, G, cid);
        pg8::EpiRelu2 E{HB, D_FF};
        pg8::gemm_phase<pg8::EpiRelu2, pg8::StaticOrder, true, true>(lds, g, S, E);
    }
#endif
    grid.sync();

#if (PH >> 7) & 1
    {
        pg8::Gemm g{HB, W2, MX, 1024, D_FF, D_FF}; pg8::StaticOrder S; S.init(MX, 1024, G, cid);
        pg8::EpiSS E{FB, 1024, SS2};
        pg8::gemm_phase<pg8::EpiSS, pg8::StaticOrder, true, true>(lds, g, S, E);
    }
#endif
    grid.sync();

#if (PH >> 8) & 1
    {
        f32x4 g3[4];
#pragma unroll
        for (int j = 0; j < 4; ++j) g3[j] = *(const f32x4*)(P.in[18] + 4 * lane + 256 * j);
        for (int m = gw; m < MX; m += NGW) {
            const float r2 = rsqrtf(SS2[m] * (1.0f / 1024.0f) + EPS);
            const unsigned long long* fi = (const unsigned long long*)(FB + (size_t)m * 1024) + lane;
#pragma unroll
            for (int j = 0; j < 4; ++j) { float* op = P.out + (size_t)m * 1024 + 4 * lane + 256 * j; const f32x4 hv = *(const f32x4*)op; const unsigned long long w = fi[64 * j];
                f32x4 mv; mv[0] = __uint_as_float((unsigned)(w & 0xffffu) << 16); mv[1] = __uint_as_float((unsigned)w & 0xffff0000u); mv[2] = __uint_as_float((unsigned)((w >> 32) & 0xffffu) << 16); mv[3] = __uint_as_float((unsigned)(w >> 32) & 0xffff0000u);
                *(f32x4*)op = hv + mv * r2 * g3[j]; }
        }
    }
#endif
}

extern "C" void kernel_launch(void* const* d_in, const int* in_sizes, int n_in, void* d_out, int out_size, void* d_ws, size_t ws_size, hipStream_t stream) {
    static int grid = 0;
    if (grid == 0) {
        if (n_in != 19 || in_sizes[0] != MX * D_MODEL || out_size != MX * D_MODEL || ws_size < WS_END) {
            fprintf(stderr, "kernel_launch: unexpected shapes (n_in %d, in0 %d, out %d, ws %zu); nothing launched\n", n_in, n_in > 0 ? in_sizes[0] : -1, out_size, ws_size); grid = -1; return; }
        int dev = 0, cus = 0, per_cu = 0;
        hipGetDevice(&dev);
        hipDeviceGetAttribute(&cus, hipDeviceAttributeMultiprocessorCount, dev);
        if (hipFuncSetAttribute((const void*)fwd_megakernel, hipFuncAttributeMaxDynamicSharedMemorySize, LDS_BYTES) != hipSuccess) { fprintf(stderr, "kernel_launch: hipFuncSetAttribute failed\n"); grid = -1; return; }
        if (hipOccupancyMaxActiveBlocksPerMultiprocessor(&per_cu, (const void*)fwd_megakernel, 512, LDS_BYTES) != hipSuccess || per_cu < 1) { fprintf(stderr, "kernel_launch: occupancy query failed (%d)\n", per_cu); grid = -1; return; }
        grid = cus;
        fprintf(stderr, "kernel_launch: cus %d per_cu %d grid %d\n", cus, per_cu, grid);
    }
    if (grid < 0) return;
    Params p{};
    for (int i = 0; i < 19; ++i) p.in[i] = (const float*)d_in[i];
    p.out = (float*)d_out; p.ws = (unsigned char*)d_ws;
    for (int i = 0; i < 32; ++i) p.inv_freq[i] = 1.0f / powf(10000.0f, (float)(2 * i) / 64.0f);
    if (hipMemsetAsync((char*)d_ws + WS_CTL, 0, 1024, stream) != hipSuccess) { fprintf(stderr, "kernel_launch: memset failed\n"); return; }
    void* args[] = {&p};
    hipError_t e = hipLaunchCooperativeKernel((const void*)fwd_megakernel, dim3(grid), dim3(512), args, LDS_BYTES, stream);
    if (e != hipSuccess) fprintf(stderr, "cooperative launch failed: %s (grid %d)\n", hipGetErrorString(e), grid);
}
```

```cpp
#ifndef PH
#define PH 0x1ff
#endif
#include <hip/hip_runtime.h>
#include <hip/hip_cooperative_groups.h>
#include <cstdio>
#include <cstdint>
#include <cmath>
namespace cg = cooperative_groups;

#define LAS __attribute__((address_space(3)))
typedef unsigned short bf16_t;
typedef short bf16x8 __attribute__((ext_vector_type(8)));
typedef float f32x4 __attribute__((ext_vector_type(4)));
typedef float f32x2 __attribute__((ext_vector_type(2)));
typedef float f32x16 __attribute__((ext_vector_type(16)));
typedef unsigned u32x4 __attribute__((ext_vector_type(4)));
typedef unsigned u32x2 __attribute__((ext_vector_type(2)));
typedef __bf16 bf16x2_t __attribute__((ext_vector_type(2)));
typedef short v4i16_t __attribute__((ext_vector_type(4)));

constexpr int D_MODEL = 1024, BATCH = 8, SEQ = 4096, N_META = 16, LTOT = SEQ + N_META;
constexpr int MX = BATCH * SEQ;
constexpr int MALL = MX + 256;
constexpr int NPROJ = 2048;
constexpr int PPITCH = 1024;
constexpr int D_FF = 4096;
constexpr float EPS = 1e-6f;
constexpr float LOG2E = 1.4426950408889634f;
constexpr float C2_DA = 0.125f * LOG2E;
constexpr float C2_MLA = 0.07216878364870322f * LOG2E;

constexpr size_t MiB = 1u << 20;
constexpr size_t WS_STAT = 0;
constexpr size_t WS_TAB = 1 * MiB;
constexpr size_t WS_CTL = 3 * MiB;
constexpr size_t WS_BAR = 3 * MiB + 16384;
constexpr size_t WS_WIN = 4 * MiB;
constexpr size_t WS_WQ = 8 * MiB;
constexpr size_t WS_WKV = 9 * MiB;
constexpr size_t WS_WO = 10 * MiB;
constexpr size_t WS_W1 = 12 * MiB;
constexpr size_t WS_W2 = 20 * MiB;
constexpr size_t WS_U = 32 * MiB;
constexpr size_t WS_MIX = 100 * MiB;
constexpr size_t WS_MIXO = 164 * MiB;
constexpr size_t WS_PROJ = 228 * MiB;
constexpr size_t WS_KD = 293 * MiB;
constexpr size_t WS_VD = 326 * MiB;
constexpr size_t WS_QM = 359 * MiB;
constexpr size_t WS_KN = 408 * MiB;
constexpr size_t WS_VM = 441 * MiB;
constexpr size_t WS_KR = 474 * MiB;
constexpr size_t WS_H = 228 * MiB;
constexpr size_t WS_END = 484 * MiB;

namespace pg8 {
constexpr int BM = 256, BK = 64, HALF = 128, HTB = HALF * BK * 2, STAGE_BYTES = 8 * HTB, NXCD = 8, WGM = 8;
__host__ __device__ __forceinline__ int lds_byte(int r, int c) { const int st = (r >> 4) * 2 + (c >> 5), rr = r & 15, cc = c & 31, ob = rr * 64 + cc * 2; return st * 1024 + (ob ^ (((ob >> 9) & 1) << 5)); }
__host__ __device__ __forceinline__ void stage_rc(int b, int& R, int& C) { const int st = b / 1024, sb = b % 1024, swz = sb ^ (((sb >> 9) & 1) << 5); R = (st >> 1) * 16 + swz / 64; C = (st & 1) * 32 + (swz % 64) / 2; }
__host__ __device__ __forceinline__ int perm32(int rho) { const int n = rho >> 4, i = rho & 15; return 8 * (i >> 2) + 4 * n + (i & 3); }
struct Unit { int pm, pn; };
struct Gemm { const bf16_t* A; const bf16_t* Bt; int M, N, K, lda; };
struct StaticOrder {
    int nM, nN, nwg, G, c;
    __host__ __device__ void init(int M, int N, int G_, int c_) { nM = M / BM; nN = N / BM; nwg = nM * nN; G = G_; c = c_; }
    __host__ __device__ bool next(int i, Unit& u) const {
        const long L = (long)i * G + c; if (L >= nwg) return false;
        int wgid = (int)L; { const int q = nwg / NXCD, r = nwg % NXCD, xcd = wgid % NXCD, off = wgid / NXCD; wgid = (xcd < r ? xcd * (q + 1) : r * (q + 1) + (xcd - r) * q) + off; }
        const int nig = WGM * nN, gid = wgid / nig, fm = gid * WGM, gsz = (nM - fm) < WGM ? (nM - fm) : WGM;
        u.pm = fm + ((wgid % nig) % gsz); u.pn = (wgid % nig) / gsz; return true;
    }
    __device__ __forceinline__ void a_ready(const Unit&) const {}
    __device__ __forceinline__ void done(const Unit&) const {}
};
__device__ __forceinline__ unsigned cvt_pk_bf16(float lo, float hi) { f32x2 v = {lo, hi}; bf16x2_t b = __builtin_convertvector(v, bf16x2_t); return __builtin_bit_cast(unsigned, b); }
__device__ __forceinline__ u32x4 pack8(const f32x4& v0, const f32x4& v1) { u32x4 w; w.x = cvt_pk_bf16(v0[0], v0[1]); w.y = cvt_pk_bf16(v0[2], v0[3]); w.z = cvt_pk_bf16(v1[0], v1[1]); w.w = cvt_pk_bf16(v1[2], v1[3]); return w; }
__device__ __forceinline__ float ssq8(const f32x4& a, const f32x4& b) { return (a[0] * a[0] + a[1] * a[1]) + (a[2] * a[2] + a[3] * a[3]) + (b[0] * b[0] + b[1] * b[1]) + (b[2] * b[2] + b[3] * b[3]); }
__device__ __forceinline__ void rope8(f32x4& v0, f32x4& v1, const float* tab, int pos, int i0) {
    const f32x4 t0 = *(const f32x4*)(tab + ((size_t)pos * 32 + i0) * 2), t1 = *(const f32x4*)(tab + ((size_t)pos * 32 + i0 + 2) * 2);
    f32x4 a, b;
    a[0] = v0[0] * t0[0] - v0[1] * t0[1]; a[1] = v0[1] * t0[0] + v0[0] * t0[1];
    a[2] = v0[2] * t0[2] - v0[3] * t0[3]; a[3] = v0[3] * t0[2] + v0[2] * t0[3];
    b[0] = v1[0] * t1[0] - v1[1] * t1[1]; b[1] = v1[1] * t1[0] + v1[0] * t1[1];
    b[2] = v1[2] * t1[2] - v1[3] * t1[3]; b[3] = v1[3] * t1[2] + v1[2] * t1[3];
    v0 = a; v1 = b;
}

struct EpiIn {
    static constexpr bool PERM = true, AFTER_DRAIN = false;
    bf16_t* PROJ; bf16_t* KD; bf16_t* VD; bf16_t* KR; float* RQ; float* RKV; const float* tab; unsigned* kmax;
    __device__ __forceinline__ void operator()(const f32x4 (&acc)[2][2][4][2], const Unit& u, int wr, int wc, int fr, int fq) const {
        const int row0 = u.pm * BM + wr * 64 + fr, cw = wc * 32 + 8 * fq, pn = u.pn;
        const bool kt = pn == 2 || pn == 3; float km0 = 0.f, km1 = 0.f;
        bf16_t* base0; bf16_t* base1; int pitch0, pitch1;
        if (pn < 2) { base0 = PROJ + pn * BM; base1 = base0 + HALF; pitch0 = pitch1 = PPITCH; }
        else if (pn < 6) { base0 = (pn < 4 ? KD : VD) + (size_t)((pn & 1) * 2) * MALL * 128; base1 = base0 + (size_t)MALL * 128; pitch0 = pitch1 = 128; }
        else if (pn == 6) { base0 = PROJ + 512; base1 = base0 + HALF; pitch0 = pitch1 = PPITCH; }
        else { base0 = PROJ + 768; pitch0 = PPITCH; base1 = KR; pitch1 = 64; }
        const bool stat = pn >= 6, kr = pn == 7;
#pragma unroll
        for (int ai = 0; ai < 2; ++ai)
#pragma unroll
            for (int m = 0; m < 4; ++m) {
                const int row = row0 + ai * HALF + m * 16;
                { const f32x4 v0 = acc[ai][0][m][0], v1 = acc[ai][0][m][1]; *(u32x4*)(base0 + (size_t)row * pitch0 + cw) = pack8(v0, v1);
                  f32x4 w0 = acc[ai][1][m][0], w1 = acc[ai][1][m][1];
                  if (kr) { if (wc < 2) { const int pos = row < MX ? N_META + (row & (SEQ - 1)) : ((row - MX) < N_META ? (row - MX) : 0);
                                rope8(w0, w1, tab, pos, 16 * wc + 4 * fq); *(u32x4*)(base1 + (size_t)row * pitch1 + cw) = pack8(w0, w1); } }
                  else *(u32x4*)(base1 + (size_t)row * pitch1 + cw) = pack8(w0, w1);
                  if (kt) { float s0 = ssq8(v0, v1), s1 = ssq8(w0, w1); s0 += __shfl_xor(s0, 16); s0 += __shfl_xor(s0, 32); s1 += __shfl_xor(s1, 16); s1 += __shfl_xor(s1, 32); km0 = fmaxf(km0, s0); km1 = fmaxf(km1, s1); }
                  if (stat) { float ss = ssq8(v0, v1); if (!kr) ss += ssq8(w0, w1);
                      ss += __shfl_xor(ss, 16); ss += __shfl_xor(ss, 32);
                      if (fq == 0) __hip_atomic_fetch_add((kr ? RKV : RQ) + row, ss, __ATOMIC_RELAXED, __HIP_MEMORY_SCOPE_AGENT); } }
                asm volatile("" ::: "memory");
            }
        if (kt) {
#pragma unroll
            for (int o = 1; o < 16; o <<= 1) { km0 = fmaxf(km0, __shfl_xor(km0, o)); km1 = fmaxf(km1, __shfl_xor(km1, o)); }
            if (fr == 0 && fq == 0) { const int h0 = (pn & 1) * 2;
                __hip_atomic_fetch_max(kmax + 2 * (2 * h0 + (wc >> 1)) + (wc & 1), __float_as_uint(km0), __ATOMIC_RELAXED, __HIP_MEMORY_SCOPE_AGENT);
                __hip_atomic_fetch_max(kmax + 2 * (2 * (h0 + 1) + (wc >> 1)) + (wc & 1), __float_as_uint(km1), __ATOMIC_RELAXED, __HIP_MEMORY_SCOPE_AGENT); }
        }
    }
};
struct EpiQ {
    static constexpr bool PERM = true, AFTER_DRAIN = false;
    bf16_t* QM; const float* RQ; const float* tab;
    __device__ __forceinline__ void operator()(const f32x4 (&acc)[2][2][4][2], const Unit& u, int wr, int wc, int fr, int fq) const {
        const int row0 = u.pm * BM + wr * 64 + fr, colt = u.pn * BM + wc * 32 + 8 * fq;
        const int blk0 = (8 * u.pn + wc) % 6, blk1 = (8 * u.pn + 4 + wc) % 6;
#pragma unroll
        for (int ai = 0; ai < 2; ++ai)
#pragma unroll
            for (int m = 0; m < 4; ++m) {
                const int row = row0 + ai * HALF + m * 16; const float sc = rsqrtf(RQ[row] * (1.0f / 256.0f) + EPS) * C2_MLA; const int pos = N_META + (row & (SEQ - 1));
                { f32x4 v0 = acc[ai][0][m][0] * sc, v1 = acc[ai][0][m][1] * sc;
                  if (blk0 >= 4) rope8(v0, v1, tab, pos, (blk0 - 4) * 16 + 4 * fq);
                  *(u32x4*)(QM + (size_t)row * 768 + colt) = pack8(v0, v1); }
                { f32x4 v0 = acc[ai][1][m][0] * sc, v1 = acc[ai][1][m][1] * sc;
                  if (blk1 >= 4) rope8(v0, v1, tab, pos, (blk1 - 4) * 16 + 4 * fq);
                  *(u32x4*)(QM + (size_t)row * 768 + colt + HALF) = pack8(v0, v1); }
                asm volatile("" ::: "memory");
            }
    }
};
struct EpiKV {
    static constexpr bool PERM = true, AFTER_DRAIN = false;
    bf16_t* KN; bf16_t* VM; const float* RKV;
    __device__ __forceinline__ void operator()(const f32x4 (&acc)[2][2][4][2], const Unit& u, int wr, int wc, int fr, int fq) const {
        const int row0 = u.pm * BM + wr * 64 + fr, c0 = wc * 32 + 8 * fq;
#pragma unroll
        for (int ai = 0; ai < 2; ++ai)
#pragma unroll
            for (int m = 0; m < 4; ++m) {
                const int row = row0 + ai * HALF + m * 16; const float sc = rsqrtf(RKV[row] * (1.0f / 128.0f) + EPS);
                *(u32x4*)(KN + ((size_t)u.pn * MALL + row) * 128 + c0) = pack8(acc[ai][0][m][0] * sc, acc[ai][0][m][1] * sc);
                *(u32x4*)(VM + ((size_t)u.pn * MALL + row) * 128 + c0) = pack8(acc[ai][1][m][0] * sc, acc[ai][1][m][1] * sc);
                asm volatile("" ::: "memory");
            }
    }
};
struct EpiSS {
    static constexpr bool PERM = true, AFTER_DRAIN = false;
    bf16_t* O; int ldc; float* SS;
    __device__ __forceinline__ void operator()(const f32x4 (&acc)[2][2][4][2], const Unit& u, int wr, int wc, int fr, int fq) const {
        const int row0 = u.pm * BM + wr * 64 + fr, colt = u.pn * BM + wc * 32 + 8 * fq;
#pragma unroll
        for (int ai = 0; ai < 2; ++ai)
#pragma unroll
            for (int m = 0; m < 4; ++m) {
                const int row = row0 + ai * HALF + m * 16; float ss = 0.f;
#pragma unroll
                for (int bj = 0; bj < 2; ++bj) { const f32x4 v0 = acc[ai][bj][m][0], v1 = acc[ai][bj][m][1];
                    *(u32x4*)(O + (size_t)row * ldc + colt + bj * HALF) = pack8(v0, v1); ss += ssq8(v0, v1); }
                ss += __shfl_xor(ss, 16); ss += __shfl_xor(ss, 32);
                if (fq == 0) __hip_atomic_fetch_add(SS + row, ss, __ATOMIC_RELAXED, __HIP_MEMORY_SCOPE_AGENT);
            }
    }
};
struct EpiRelu2 {
    static constexpr bool PERM = true, AFTER_DRAIN = false;
    bf16_t* O; int ldc;
    __device__ __forceinline__ void operator()(const f32x4 (&acc)[2][2][4][2], const Unit& u, int wr, int wc, int fr, int fq) const {
        const int row0 = u.pm * BM + wr * 64 + fr, colt = u.pn * BM + wc * 32 + 8 * fq;
#pragma unroll
        for (int ai = 0; ai < 2; ++ai)
#pragma unroll
            for (int m = 0; m < 4; ++m) {
                const int row = row0 + ai * HALF + m * 16;
#pragma unroll
                for (int bj = 0; bj < 2; ++bj) { f32x4 v0 = acc[ai][bj][m][0], v1 = acc[ai][bj][m][1];
#pragma unroll
                    for (int e = 0; e < 4; ++e) { const float a = fmaxf(v0[e], 0.f), b = fmaxf(v1[e], 0.f); v0[e] = a * a; v1[e] = b * b; }
                    *(u32x4*)(O + (size_t)row * ldc + colt + bj * HALF) = pack8(v0, v1); }
            }
    }
};

template <class Epi, class Sched, bool ALIGN_EPI = false, bool SP2 = false>
__device__ __forceinline__ void gemm_phase(LAS unsigned char* lds, const Gemm g, const Sched& S, const Epi& E) {
    int tid_ = threadIdx.x; asm volatile("" : "+v"(tid_));
    const int tid = tid_, wid = __builtin_amdgcn_readfirstlane(tid >> 6), lane = tid & 63, wr = wid >> 2, wc = wid & 3, fr = lane & 15, fq = lane >> 4;
    int K_ = g.K; asm volatile("" : "+s"(K_));
    const int K = K_, nt = K / BK, lda = g.lda;
    unsigned voffA[2], voffB[2];
#pragma unroll
    for (int i = 0; i < 2; ++i) { int R, C; stage_rc(tid * 16 + i * 8192, R, C); const int Rb = Epi::PERM ? ((R & ~31) + perm32(R & 31)) : R;
        voffA[i] = (unsigned)(R * lda + C) * 2u; voffB[i] = (unsigned)(Rb * K + C) * 2u; }
    const size_t kstep = (size_t)(BK * 2);
    const size_t hstepA = (size_t)HALF * lda * 2, hstepB = (size_t)HALF * K * 2;
    const size_t tstepA = 2 * hstepA, tstepB = 2 * hstepB;
    const unsigned ldsw = (unsigned)wid * 1024u;
    const int aoff = lds_byte(wr * 64 + fr, fq * 8), boff = lds_byte(wc * 32 + fr, fq * 8);
#define PG8_SA(b, h) (((b) * 2 + (h)) * HTB)
#define PG8_SB(b, h) ((4 + (b) * 2 + (h)) * HTB)
#define PG8_STAGE(bufoff, gbase, voff) do { _Pragma("unroll") for (int _i = 0; _i < 2; ++_i) \
        __builtin_amdgcn_global_load_lds((const unsigned*)((const char*)(gbase) + (voff)[_i]), (LAS unsigned*)(lds + (bufoff) + ldsw + _i * 8192), 16, 0, 0); } while (0)
#define PG8_LDA(dst, b, h) do { _Pragma("unroll") for (int m = 0; m < 4; ++m) _Pragma("unroll") for (int k = 0; k < 2; ++k) dst[m][k] = *(const LAS bf16x8*)(lds + PG8_SA(b, h) + aoff + m * 2048 + k * 1024); } while (0)
#define PG8_LDB(dst, b, h) do { _Pragma("unroll") for (int n = 0; n < 2; ++n) _Pragma("unroll") for (int k = 0; k < 2; ++k) dst[n][k] = *(const LAS bf16x8*)(lds + PG8_SB(b, h) + boff + n * 2048 + k * 1024); } while (0)
#define PG8_MMA(ai, bj, At, Bt) do { __builtin_amdgcn_s_setprio(1); _Pragma("unroll") for (int m = 0; m < 4; ++m) _Pragma("unroll") for (int n = 0; n < 2; ++n) _Pragma("unroll") for (int k = 0; k < 2; ++k) \
        acc[ai][bj][m][n] = __builtin_amdgcn_mfma_f32_16x16x32_bf16(Bt[n][k], At[m][k], acc[ai][bj][m][n], 0, 0, 0); __builtin_amdgcn_s_setprio(0); } while (0)
#define PG8_WAIT_V(n) asm volatile("s_waitcnt vmcnt(" #n ")" ::: "memory")
#define PG8_WAIT_L(n) asm volatile("s_waitcnt lgkmcnt(" #n ")" ::: "memory")
#define PG8_BAR __builtin_amdgcn_s_barrier()
#define PG8_SCHED __builtin_amdgcn_sched_barrier(0)
    Unit cur, nxt; int ui = 0;
    if (!S.next(0, cur)) return;
    f32x4 acc[2][2][4][2];
#pragma unroll
    for (int a = 0; a < 2; ++a)
#pragma unroll
        for (int b = 0; b < 2; ++b)
#pragma unroll
            for (int m = 0; m < 4; ++m)
#pragma unroll
                for (int n = 0; n < 2; ++n) acc[a][b][m][n] = (f32x4){0.f, 0.f, 0.f, 0.f};
    bf16x8 At[4][2], B0[2][2], B1[2][2];
    const char* cA = (const char*)g.A + (size_t)cur.pm * tstepA; const char* cB = (const char*)g.Bt + (size_t)cur.pn * tstepB;
    S.a_ready(cur);
    if constexpr (SP2) {
        PG8_STAGE(PG8_SB(0, 0), cB, voffB); PG8_STAGE(PG8_SB(0, 1), cB + hstepB, voffB); PG8_STAGE(PG8_SA(0, 0), cA, voffA); PG8_STAGE(PG8_SA(0, 1), cA + hstepA, voffA);
        if (wr == 1) PG8_BAR;
        PG8_WAIT_V(2); PG8_BAR;
        PG8_STAGE(PG8_SB(1, 0), cB + kstep, voffB); PG8_STAGE(PG8_SA(1, 0), cA + kstep, voffA); PG8_STAGE(PG8_SB(1, 1), cB + hstepB + kstep, voffB);
        PG8_WAIT_V(6); PG8_BAR;
    } else {
        PG8_STAGE(PG8_SB(0, 0), cB, voffB); PG8_STAGE(PG8_SA(0, 0), cA, voffA); PG8_STAGE(PG8_SB(0, 1), cB + hstepB, voffB); PG8_STAGE(PG8_SA(0, 1), cA + hstepA, voffA);
        if (wr == 1) PG8_BAR;
        PG8_WAIT_V(4); PG8_BAR;
        PG8_STAGE(PG8_SB(1, 0), cB + kstep, voffB); PG8_STAGE(PG8_SA(1, 0), cA + kstep, voffA); PG8_STAGE(PG8_SB(1, 1), cB + hstepB + kstep, voffB);
        PG8_WAIT_V(6); PG8_BAR;
    }
    for (;;) {
        const bool has_next = S.next(ui + 1, nxt);
        const char* nA = has_next ? (const char*)g.A + (size_t)nxt.pm * tstepA : cA; const char* nB = has_next ? (const char*)g.Bt + (size_t)nxt.pn * tstepB : cB;
#pragma clang loop unroll(disable)
        for (int t = 0; t < nt; t += 2) {
            const bool last = (t == nt - 2);
            const char* a1 = cA + (size_t)(t + 1) * kstep;
            const char* a2 = last ? nA : cA + (size_t)(t + 2) * kstep; const char* b2 = last ? nB : cB + (size_t)(t + 2) * kstep;
            const char* a3 = a2 + kstep; const char* b3 = b2 + kstep;
            if (last && has_next) S.a_ready(nxt);
            if constexpr (SP2) {
            PG8_LDB(B0, 0, 0); PG8_LDB(B1, 0, 1); PG8_SCHED; PG8_LDA(At, 0, 0); PG8_STAGE(PG8_SA(1, 1), a1 + hstepA, voffA);
            PG8_WAIT_V(8); PG8_WAIT_L(0); PG8_BAR; PG8_MMA(0, 0, At, B0); PG8_MMA(0, 1, At, B1); PG8_BAR; PG8_SCHED;
            PG8_LDA(At, 0, 1); PG8_STAGE(PG8_SB(0, 0), b2, voffB); PG8_STAGE(PG8_SB(0, 1), b2 + hstepB, voffB); PG8_STAGE(PG8_SA(0, 0), a2, voffA);
            PG8_WAIT_V(8); PG8_WAIT_L(0); PG8_BAR; PG8_MMA(1, 0, At, B0); PG8_MMA(1, 1, At, B1); PG8_BAR; PG8_SCHED;
            PG8_LDB(B0, 1, 0); PG8_LDB(B1, 1, 1); PG8_SCHED; PG8_LDA(At, 1, 0); PG8_STAGE(PG8_SA(0, 1), a2 + hstepA, voffA);
            PG8_WAIT_V(8); PG8_WAIT_L(0); PG8_BAR; PG8_MMA(0, 0, At, B0); PG8_MMA(0, 1, At, B1); PG8_BAR; PG8_SCHED;
            PG8_LDA(At, 1, 1); PG8_STAGE(PG8_SB(1, 0), b3, voffB); PG8_STAGE(PG8_SB(1, 1), b3 + hstepB, voffB); PG8_STAGE(PG8_SA(1, 0), a3, voffA);
            PG8_WAIT_V(8); PG8_WAIT_L(0); PG8_BAR; PG8_MMA(1, 0, At, B0); PG8_MMA(1, 1, At, B1); PG8_BAR; PG8_SCHED;
            } else {
            PG8_LDB(B0, 0, 0); PG8_SCHED; PG8_LDA(At, 0, 0); PG8_STAGE(PG8_SA(1, 1), a1 + hstepA, voffA);
            PG8_WAIT_L(8); PG8_BAR; PG8_WAIT_L(0); PG8_MMA(0, 0, At, B0); PG8_BAR; PG8_SCHED;
            PG8_LDB(B1, 0, 1); PG8_STAGE(PG8_SB(0, 0), b2, voffB);
            PG8_BAR; PG8_WAIT_L(0); PG8_MMA(0, 1, At, B1); PG8_BAR;
            PG8_LDA(At, 0, 1); PG8_STAGE(PG8_SA(0, 0), a2, voffA);
            PG8_BAR; PG8_WAIT_L(0); PG8_MMA(1, 0, At, B0); PG8_BAR; PG8_SCHED;
            PG8_STAGE(PG8_SB(0, 1), b2 + hstepB, voffB);
            PG8_WAIT_V(6); PG8_BAR; PG8_MMA(1, 1, At, B1); PG8_BAR;
            PG8_LDB(B0, 1, 0); PG8_SCHED; PG8_LDA(At, 1, 0); PG8_STAGE(PG8_SA(0, 1), a2 + hstepA, voffA);
            PG8_WAIT_L(8); PG8_BAR; PG8_WAIT_L(0); PG8_MMA(0, 0, At, B0); PG8_BAR; PG8_SCHED;
            PG8_LDB(B1, 1, 1); PG8_STAGE(PG8_SB(1, 0), b3, voffB);
            PG8_BAR; PG8_WAIT_L(0); PG8_MMA(0, 1, At, B1); PG8_BAR;
            PG8_LDA(At, 1, 1); PG8_STAGE(PG8_SA(1, 0), a3, voffA);
            PG8_BAR; PG8_WAIT_L(0); PG8_MMA(1, 0, At, B0); PG8_BAR; PG8_SCHED;
            PG8_STAGE(PG8_SB(1, 1), b3 + hstepB, voffB);
            PG8_WAIT_V(6); PG8_BAR; PG8_MMA(1, 1, At, B1); PG8_BAR;
            }
        }
        if constexpr (ALIGN_EPI) { if (wr == 0) PG8_BAR; }
        if constexpr (!Epi::AFTER_DRAIN) { E(acc, cur, wr, wc, fr, fq); S.done(cur); }
        if (!has_next) break;
#pragma unroll
        for (int a = 0; a < 2; ++a)
#pragma unroll
            for (int b = 0; b < 2; ++b)
#pragma unroll
                for (int m = 0; m < 4; ++m)
#pragma unroll
                    for (int n = 0; n < 2; ++n) acc[a][b][m][n] = (f32x4){0.f, 0.f, 0.f, 0.f};
        cur = nxt; cA = nA; cB = nB; ++ui;
        if constexpr (ALIGN_EPI) { if (wr == 1) PG8_BAR; }
    }
    PG8_WAIT_V(0);
    if constexpr (!ALIGN_EPI) { if (wr == 0) PG8_BAR; }
    PG8_BAR;
#undef PG8_SA
#undef PG8_SB
#undef PG8_STAGE
#undef PG8_LDA
#undef PG8_LDB
#undef PG8_MMA
#undef PG8_WAIT_V
#undef PG8_WAIT_L
#undef PG8_BAR
#undef PG8_SCHED
}
}

namespace att {
constexpr int VOFF = 26624, BUFB = 43008, NPIECE = 42;
constexpr int KP_DA = 144, KCOMP_DA = 64 * KP_DA;
constexpr int KNP = 272, KR_OFF = 64 * KNP, KRP = 144;
struct Tensors { const bf16_t* PROJ; const bf16_t* KD; const bf16_t* VD; const bf16_t* QM; const bf16_t* KN; const bf16_t* VM; const bf16_t* KR; bf16_t* MIX; const float* gsub; const unsigned* kmax; };
__device__ __forceinline__ float swap_max(float v) { auto rr = __builtin_amdgcn_permlane32_swap(__float_as_uint(v), __float_as_uint(v), false, false); return fmaxf(__uint_as_float(rr[0]), __uint_as_float(rr[1])); }
__device__ __forceinline__ float swap_sum(float v) { auto rr = __builtin_amdgcn_permlane32_swap(__float_as_uint(v), __float_as_uint(v), false, false); return __uint_as_float(rr[0]) + __uint_as_float(rr[1]); }
__device__ __forceinline__ unsigned off_b(unsigned row, unsigned ch) { return 256u * row + 16u * (ch ^ (((row & 3) << 2) | ((row >> 2) & 3))); }
__device__ __forceinline__ unsigned tr_read_addr(unsigned lane, unsigned c, unsigned ks, unsigned t) {
    const unsigned h = lane >> 5, blk = (lane >> 4) & 1, q = (lane & 15) >> 2, p = lane & 3;
    return off_b(16 * ks + 8 * h + 4 * t + q, 4 * c + 2 * blk + (p >> 1)) + 8 * (p & 1);
}
__device__ __forceinline__ bf16x8 pack_p(const f32x16& p, int o) {
    u32x4 w; w.x = pg8::cvt_pk_bf16(p[o + 0], p[o + 1]); w.y = pg8::cvt_pk_bf16(p[o + 2], p[o + 3]); w.z = pg8::cvt_pk_bf16(p[o + 4], p[o + 5]); w.w = pg8::cvt_pk_bf16(p[o + 6], p[o + 7]);
    return __builtin_bit_cast(bf16x8, w);
}

__device__ __forceinline__ void glds16(const void* gsrc, unsigned lds_dst) { unsigned keep;
    asm volatile("s_mov_b32 %0, m0\n\ts_mov_b32 m0, %2\n\ts_nop 0\n\tglobal_load_lds_dwordx4 %1, off\n\ts_mov_b32 m0, %0" : "=&s"(keep) : "v"(gsrc), "s"(lds_dst) : "memory"); }
#define ATT_WAITBAR(N) asm volatile("s_waitcnt vmcnt(" #N ") lgkmcnt(0)\n\ts_barrier" ::: "memory")
__device__ __forceinline__ float mx3(float a, float b, float c) { return __builtin_fmaxf(__builtin_fmaxf(a, b), c); }
template <bool DA>
__device__ __forceinline__ void attn_unit(LAS unsigned char* lds, const Tensors& T, int b, int h, int u, float lam) {
    int tid_ = threadIdx.x; asm volatile("" : "+v"(tid_));
    const int tid = tid_, lane = tid & 63, q32 = lane & 31, hi = lane >> 5;
    const int wid = __builtin_amdgcn_readfirstlane(tid >> 6);
    const int comp = DA ? (wid >> 2) : 0, wq = DA ? (wid & 3) : wid;
    unsigned voff[6];
#pragma unroll
    for (int i = 0; i < 6; ++i) {
        const unsigned pi = wid + 8 * i, o = pi * 1024 + lane * 16; unsigned v = 0;
        if (o < (unsigned)VOFF) {
            if (DA) { const unsigned cp = o / KCOMP_DA, rem = o - cp * KCOMP_DA, key = rem / KP_DA; unsigned cc = (rem - key * KP_DA) >> 4; if (cc == 8) cc = 0; v = (key & 63) * 256 + (cp & 1) * 128 + cc * 16; }
            else if (o < (unsigned)KR_OFF) { const unsigned key = o / KNP; unsigned cc = (o - key * KNP) >> 4; if (cc == 16) cc = 0; v = key * 256 + cc * 16; }
            else { const unsigned o2 = o - KR_OFF, key = o2 / KRP; unsigned cc = (o2 - key * KRP) >> 4; if (cc == 8) cc = 0; v = (key & 63) * 128 + cc * 16; }
        } else {
            const unsigned ov = o - VOFF, img = (ov >> 13) & 1, slot = (ov & 8191) >> 4, rho = slot >> 4, chp = slot & 15;
            const unsigned ch = chp ^ (((rho & 3) << 2) | ((rho >> 2) & 3)), kk = (rho & ~12u) | ((rho & 4) << 1) | ((rho & 8) >> 1), key = 32 * img + kk;
            v = key * 256 + ch * 16;
        }
        voff[i] = v;
    }
    const unsigned lds0 = (unsigned)(size_t)lds;
    const int npiece = DA ? (wid < 2 ? 5 : 4) : (wid < 2 ? 6 : 5);
    constexpr int QPU = DA ? 128 : 256, CPU = QPU / 64;
    const int NT = CPU * u + CPU + 1;
    const int tmax = CPU * u + (wq >> 1) + 1;
    auto issue = [&](int tt, int bufoff) {
        const size_t row0 = (tt == 0) ? (size_t)MX : (size_t)b * SEQ + (size_t)(tt - 1) * 64;
        const char *pK, *pK2, *pV;
        const size_t hrow = ((size_t)h * MALL + row0) * 256;
        if (DA) { pK = (const char*)T.KD + hrow; pK2 = pK; pV = (const char*)T.VD + hrow; }
        else { pK = (const char*)T.KN + hrow; pK2 = (const char*)T.KR + row0 * 128; pV = (const char*)T.VM + hrow; }
#pragma unroll
        for (int i = 0; i < 6; ++i) {
            const int pi = wid + 8 * i;
            if (pi >= NPIECE) continue;
            if (DA && pi >= 18 && pi < 26) continue;
            const char* base = (pi >= 26) ? pV : ((!DA && pi >= 17) ? pK2 : pK);
            glds16(base + voff[i], (unsigned)__builtin_amdgcn_readfirstlane((int)(lds0 + bufoff + pi * 1024)));
        }
    };
    issue(NT - 1, 0); issue(NT - 2, BUFB);
    const int qx = u * QPU + wq * 32 + q32;
    const size_t qrow = (size_t)b * SEQ + qx;
    constexpr int NQF = DA ? 4 : 12;
    bf16x8 qf[NQF];
    if (DA) { const bf16_t* qp = T.PROJ + qrow * PPITCH + 128 * h + 64 * comp + 8 * hi;
#pragma unroll
        for (int s = 0; s < 4; ++s) qf[s] = *(const bf16x8*)(qp + 16 * s); }
    else { const bf16_t* qp = T.QM + qrow * 768 + 192 * h + 8 * hi;
#pragma unroll
        for (int s = 0; s < 12; ++s) qf[s] = *(const bf16x8*)(qp + 16 * s); }
#pragma unroll
    for (int s = 0; s < NQF; ++s) asm volatile("" : "+v"(qf[s]));
    float qbound = 0.f;
    LAS unsigned* vote = (LAS unsigned*)(lds + 131072) + 8;
    if (DA) {
        float ss = 0.f;
#pragma unroll
        for (int s = 0; s < 4; ++s)
#pragma unroll
            for (int e = 0; e < 8; ++e) { const float v = __uint_as_float(((unsigned)(unsigned short)qf[s][e]) << 16); ss += v * v; }
        ss = swap_sum(ss);
        const float km = __uint_as_float(__hip_atomic_load(T.kmax + 2 * (2 * h + comp), __ATOMIC_RELAXED, __HIP_MEMORY_SCOPE_AGENT)) + __uint_as_float(__hip_atomic_load(T.kmax + 2 * (2 * h + comp) + 1, __ATOMIC_RELAXED, __HIP_MEMORY_SCOPE_AGENT));
        qbound = sqrtf(ss * km) * 1.01f;
        if (tid < 3) vote[tid] = 0u;
    }
    bool wdone = false; int vi = 0;
    f32x16 O[4]; float mrun = -1e30f, lrun = 0.f;
#pragma unroll
    for (int cc = 0; cc < 4; ++cc)
#pragma unroll
        for (int r = 0; r < 16; ++r) O[cc][r] = 0.f;
    const float slope2 = DA ? exp2f(-2.0f * (float)(h + 1)) * LOG2E : 0.f;
    const float H64 = 64.0f * slope2, H32 = 32.0f * slope2;
    f32x16 cvec;
#pragma unroll
    for (int r = 0; r < 16; ++r) cvec[r] = DA ? slope2 * (float)((r & 3) + 8 * (r >> 2) + 4 * hi) : 0.f;
    unsigned vad[4][2];
#pragma unroll
    for (int cc = 0; cc < 4; ++cc)
#pragma unroll
        for (int t = 0; t < 2; ++t) vad[cc][t] = tr_read_addr(lane, cc, 0, t);
    if (npiece == 6) ATT_WAITBAR(6); else if (npiece == 5) ATT_WAITBAR(5); else ATT_WAITBAR(4);

    int bo0 = 0, bo1 = BUFB, bo2 = 2 * BUFB;
    for (int tt = NT - 1; tt >= 0; --tt) {
        if (tt >= 2) issue(tt - 2, bo2);
        if (tt <= tmax) {
            LAS unsigned char* kb = lds + bo0;
            LAS unsigned char* vb = kb + VOFF;
            f32x16 p0, p1;
#define ATT_VFRAG(dst, cc_, kap_) do { const v4i16_t lo_ = __builtin_amdgcn_ds_read_tr16_b64_v4i16((LAS v4i16_t*)(vb + vad[cc_][0] + ((kap_) & 1) * 4096 + ((kap_) >> 1) * 8192)); \
                const v4i16_t hh_ = __builtin_amdgcn_ds_read_tr16_b64_v4i16((LAS v4i16_t*)(vb + vad[cc_][1] + ((kap_) & 1) * 4096 + ((kap_) >> 1) * 8192)); \
                dst = (bf16x8){lo_[0], lo_[1], lo_[2], lo_[3], hh_[0], hh_[1], hh_[2], hh_[3]}; } while (0)
#define ATT_SB() __builtin_amdgcn_sched_barrier(0)
            bf16x8 va[4], vbf[4];
            if (DA) {
                mrun += H64;
                LAS unsigned char* kp = kb + comp * KCOMP_DA + q32 * KP_DA + hi * 16;
                bf16x8 kf[8];
#pragma unroll
                for (int s = 0; s < 4; ++s) { kf[2 * s] = *(const LAS bf16x8*)(kp + 32 * s); kf[2 * s + 1] = *(const LAS bf16x8*)(kp + 32 * KP_DA + 32 * s); }
                ATT_SB();
                p0 = __builtin_amdgcn_mfma_f32_32x32x16_bf16(kf[0], qf[0], cvec, 0, 0, 0); p1 = __builtin_amdgcn_mfma_f32_32x32x16_bf16(kf[1], qf[0], cvec, 0, 0, 0);
#pragma unroll
                for (int s = 1; s < 4; ++s) { p0 = __builtin_amdgcn_mfma_f32_32x32x16_bf16(kf[2 * s], qf[s], p0, 0, 0, 0); p1 = __builtin_amdgcn_mfma_f32_32x32x16_bf16(kf[2 * s + 1], qf[s], p1, 0, 0, 0); }
                ATT_SB();
            } else {
                const f32x16 z16 = {0.f, 0.f, 0.f, 0.f, 0.f, 0.f, 0.f, 0.f, 0.f, 0.f, 0.f, 0.f, 0.f, 0.f, 0.f, 0.f};
                LAS unsigned char* kp = kb + q32 * KNP + hi * 16;
                LAS unsigned char* kp2 = kb + KR_OFF + q32 * KRP + hi * 16;
                bf16x8 kA[4], kB[4];
#define ATT_KADDR(s_) ((s_) < 8 ? kp + 32 * (s_) : kp2 + 32 * ((s_) - 8))
#define ATT_KLOAD(dst, j_) do { dst[0] = *(const LAS bf16x8*)(ATT_KADDR(2 * (j_))); dst[1] = *(const LAS bf16x8*)(ATT_KADDR(2 * (j_)) + ((j_) < 4 ? 32 * KNP : 32 * KRP)); \
                dst[2] = *(const LAS bf16x8*)(ATT_KADDR(2 * (j_) + 1)); dst[3] = *(const LAS bf16x8*)(ATT_KADDR(2 * (j_) + 1) + ((j_) < 4 ? 32 * KNP : 32 * KRP)); } while (0)
#define ATT_KMM(src, j_) do { p0 = __builtin_amdgcn_mfma_f32_32x32x16_bf16(src[0], qf[2 * (j_)], p0, 0, 0, 0); p1 = __builtin_amdgcn_mfma_f32_32x32x16_bf16(src[1], qf[2 * (j_)], p1, 0, 0, 0); \
                p0 = __builtin_amdgcn_mfma_f32_32x32x16_bf16(src[2], qf[2 * (j_) + 1], p0, 0, 0, 0); p1 = __builtin_amdgcn_mfma_f32_32x32x16_bf16(src[3], qf[2 * (j_) + 1], p1, 0, 0, 0); } while (0)
                ATT_KLOAD(kA, 0); ATT_KLOAD(kB, 1); ATT_SB();
                p0 = z16; p1 = z16;
                ATT_KMM(kA, 0); ATT_SB(); ATT_KLOAD(kA, 2); ATT_SB();
                ATT_KMM(kB, 1); ATT_SB(); ATT_KLOAD(kB, 3); ATT_SB();
                ATT_KMM(kA, 2); ATT_SB(); ATT_KLOAD(kA, 4); ATT_SB();
                ATT_KMM(kB, 3); ATT_SB(); ATT_KLOAD(kB, 5); ATT_SB();
                ATT_KMM(kA, 4); ATT_SB(); ATT_KMM(kB, 5); ATT_SB();
            }
            float off0 = 0.f, off1 = 0.f;
            if (DA) {
                off1 = H32;
                if (tt == 0) off0 = 48.0f * slope2;
                if (tt == tmax) {
                    const float qoff = (float)(qx - 64 * (tt - 1)), dq = qoff - (float)(4 * hi);
#pragma unroll
                    for (int r = 0; r < 16; ++r) { const float cr = (float)((r & 3) + 8 * (r >> 2));
                        p0[r] = (p0[r] - cvec[r]) - slope2 * fabsf(dq - cr); p1[r] = (p1[r] - cvec[r]) - slope2 * fabsf(dq - 32.0f - cr); }
                    off0 = slope2 * qoff; off1 = off0;
                }
            }
            if (tt == 0) {
#pragma unroll
                for (int r = 0; r < 16; ++r) { if (r >= 8) p0[r] = -1e30f; p1[r] = -1e30f; }
            }
            float ra = mx3(p0[0], p0[1], p0[2]), rb = mx3(p1[0], p1[1], p1[2]);
            ra = mx3(ra, p0[3], p0[4]); rb = mx3(rb, p1[3], p1[4]);
#pragma unroll
            for (int r = 5; r < 15; r += 2) { ra = mx3(ra, p0[r], p0[r + 1]); rb = mx3(rb, p1[r], p1[r + 1]); }
            ra = fmaxf(ra, p0[15]); rb = fmaxf(rb, p1[15]);
            const float rm = swap_max(fmaxf(ra + off0, rb + off1));
            const bool skip = DA && __all(rm - mrun < -40.0f);
            if (!skip) {
                const float mn = fmaxf(mrun, rm), alpha = __builtin_amdgcn_exp2f(mrun - mn);
                mrun = mn;
                const float m0 = mn - off0, m1 = mn - off1;
                float sum = 0.f;
#pragma unroll
                for (int r = 0; r < 16; ++r) { p0[r] = __builtin_amdgcn_exp2f(p0[r] - m0); p1[r] = __builtin_amdgcn_exp2f(p1[r] - m1); sum += p0[r] + p1[r]; }
                ATT_SB();
#pragma unroll
                for (int cc = 0; cc < 4; ++cc) ATT_VFRAG(va[cc], cc, 0);
                ATT_SB();
                lrun = lrun * alpha + sum;
                if (__any(alpha != 1.0f)) {
#pragma unroll
                    for (int cc = 0; cc < 4; ++cc)
#pragma unroll
                        for (int r = 0; r < 16; ++r) O[cc][r] *= alpha;
                }
                bf16x8 pf[4]; pf[0] = pack_p(p0, 0); pf[1] = pack_p(p0, 8); pf[2] = pack_p(p1, 0); pf[3] = pack_p(p1, 8);
#define ATT_PVMM(src, kap_) do { _Pragma("unroll") for (int cc = 0; cc < 4; ++cc) O[cc] = __builtin_amdgcn_mfma_f32_32x32x16_bf16(src[cc], pf[kap_], O[cc], 0, 0, 0); } while (0)
#define ATT_PVLD(dst, kap_) do { _Pragma("unroll") for (int cc = 0; cc < 4; ++cc) ATT_VFRAG(dst[cc], cc, kap_); } while (0)
                ATT_SB(); ATT_PVLD(vbf, 1); ATT_SB();
                ATT_PVMM(va, 0); ATT_SB(); ATT_PVLD(va, 2); ATT_SB();
                ATT_PVMM(vbf, 1); ATT_SB(); ATT_PVLD(vbf, 3); ATT_SB();
                ATT_PVMM(va, 2); ATT_SB(); ATT_PVMM(vbf, 3); ATT_SB();
            }
        }
        if (DA) {
            if (tt <= tmax && !wdone) wdone = __all(qbound + 63.0f * slope2 - (mrun + H64) < -40.0f);
            const int vn = vi == 2 ? 0 : vi + 1;
            if (tid == 0) vote[vn] = 0u;
            if (wdone && lane == 0) __hip_atomic_fetch_add(vote + vi, 1u, __ATOMIC_RELAXED, __HIP_MEMORY_SCOPE_WORKGROUP);
        }
        if (tt >= 2) { if (npiece == 6) ATT_WAITBAR(6); else if (npiece == 5) ATT_WAITBAR(5); else ATT_WAITBAR(4); }
        else ATT_WAITBAR(0);
        { const int t_ = bo0; bo0 = bo1; bo1 = bo2; bo2 = t_; }
        if (DA) {
            const unsigned nv = *(volatile LAS unsigned*)(vote + vi);
            vi = vi == 2 ? 0 : vi + 1;
            if (nv == 8u && tt > 0) { ATT_WAITBAR(0); break; }
        }
    }
    if (DA) {
        LAS float* xch = (LAS float*)lds + (size_t)wq * 64 * 64 + lane;
        const float i1 = (comp ? lam : 1.0f) / swap_sum(lrun);
        if (comp == 1) {
#pragma unroll
            for (int cc = 0; cc < 4; ++cc)
#pragma unroll
                for (int r = 0; r < 16; ++r) xch[(cc * 16 + r) * 64] = O[cc][r] * i1;
        }
        __syncthreads();
        if (comp == 0) {
            float ss = 0.f;
#pragma unroll
            for (int cc = 0; cc < 4; ++cc)
#pragma unroll
                for (int r = 0; r < 16; ++r) { const float o = O[cc][r] * i1 - xch[(cc * 16 + r) * 64]; O[cc][r] = o; ss += o * o; if ((r & 7) == 7) asm volatile("" ::: "memory"); }
            ss = swap_sum(ss);
            const float rn = rsqrtf(ss * (1.0f / 128.0f) + EPS) * 0.8f;
            bf16_t* op = T.MIX + qrow * 1024 + 128 * h + 4 * hi;
#pragma unroll
            for (int cc = 0; cc < 4; ++cc)
#pragma unroll
                for (int g = 0; g < 4; ++g) { const f32x4 gs = *(const f32x4*)(T.gsub + 32 * cc + 8 * g + 4 * hi);
                    u32x2 w; w.x = pg8::cvt_pk_bf16(O[cc][4 * g] * rn * gs[0], O[cc][4 * g + 1] * rn * gs[1]); w.y = pg8::cvt_pk_bf16(O[cc][4 * g + 2] * rn * gs[2], O[cc][4 * g + 3] * rn * gs[3]);
                    *(u32x2*)(op + 32 * cc + 8 * g) = w; asm volatile("" ::: "memory"); }
        }
        __syncthreads();
    } else {
        const float i1 = 1.0f / swap_sum(lrun);
        bf16_t* op = T.MIX + qrow * 1024 + 512 + 128 * h + 4 * hi;
#pragma unroll
        for (int cc = 0; cc < 4; ++cc)
#pragma unroll
            for (int g = 0; g < 4; ++g) { u32x2 w; w.x = pg8::cvt_pk_bf16(O[cc][4 * g] * i1, O[cc][4 * g + 1] * i1); w.y = pg8::cvt_pk_bf16(O[cc][4 * g + 2] * i1, O[cc][4 * g + 3] * i1);
                *(u32x2*)(op + 32 * cc + 8 * g) = w; }
    }
}
}

#define XB_TMO      128
#define XB_XCNT(j)  (256  + 64 * (j))
#define XB_XSUB(j)  (1280 + 64 * (j))
#define XB_XGEN(j)  (2304 + 64 * (j))
#define XB_TOP      3328
#define XB_TOPGEN   3392
#define XCD_BAR_WORDS 3456
#define XB_SPIN_CAP (1u << 18)
__device__ __forceinline__ unsigned xb_ld(unsigned* p)              { return __hip_atomic_load(p, __ATOMIC_RELAXED, __HIP_MEMORY_SCOPE_AGENT); }
__device__ __forceinline__ unsigned xb_add(unsigned* p, unsigned v) { return __hip_atomic_fetch_add(p, v, __ATOMIC_RELAXED, __HIP_MEMORY_SCOPE_AGENT); }
__device__ __forceinline__ unsigned xb_xcc_id() { return (unsigned)__builtin_amdgcn_s_getreg((3 << 11) | 20) & 0xFu; }
#define XB_SPIN(cond, bar) do { unsigned _sp = 0; while (cond) { __builtin_amdgcn_s_sleep(1); \
    if ((++_sp & 255u) == 0u) { if (xb_ld(&(bar)[XB_TMO])) break; if (_sp > XB_SPIN_CAP) { atomicAdd(&(bar)[XB_TMO], 1u); break; } } } } while (0)
struct XcdBarrier { unsigned* bar; unsigned x; volatile LAS unsigned* st; };
__device__ __forceinline__ XcdBarrier xcd_barrier_post(unsigned* bar, volatile LAS unsigned* st) {
    XcdBarrier b; b.bar = bar; b.x = xb_xcc_id(); b.st = st;
    if (threadIdx.x == 0) (void)xb_add(&bar[XB_XCNT(b.x)], 1u);
    return b;
}
__device__ __forceinline__ void xcd_barrier_complete(unsigned* bar, unsigned x, unsigned& nloc, unsigned& nx) {
    const unsigned G = gridDim.x * gridDim.y * gridDim.z;
    unsigned sum, cnt, mine, sp = 0u;
    for (;;) {
        sum = 0u; cnt = 0u; mine = 0u;
#pragma unroll
        for (unsigned j = 0; j < 16; ++j) { const unsigned c = xb_ld(&bar[XB_XCNT(j)]); sum += c; cnt += (c > 0u) ? 1u : 0u; mine = (j == x) ? c : mine; }
        if (sum == G) break;
        __builtin_amdgcn_s_sleep(1);
        if ((++sp & 255u) == 0u) { if (xb_ld(&bar[XB_TMO])) break; if (sp > XB_SPIN_CAP) { atomicAdd(&bar[XB_TMO], 1u); break; } }
    }
    nloc = mine > 0u ? mine : 1u; nx = cnt > 0u ? cnt : 1u;
}
__device__ __forceinline__ void xcd_barrier(const XcdBarrier& b) {
    asm volatile("s_waitcnt vmcnt(0)" ::: "memory");
    __syncthreads();
    if (threadIdx.x == 0) {
        unsigned* bar = b.bar;
        __builtin_amdgcn_s_waitcnt(0);
        unsigned nloc = b.st[0], nx = b.st[1];
        if (nloc == 0u) { xcd_barrier_complete(bar, b.x, nloc, nx); b.st[0] = nloc; b.st[1] = nx; }
        const unsigned old = xb_add(&bar[XB_XSUB(b.x)], 1u);
        const unsigned gen = old / nloc;
        if (old + 1u == (gen + 1u) * nloc) {
            __builtin_amdgcn_fence(__ATOMIC_RELEASE, "agent");
            asm volatile("s_waitcnt vmcnt(0)" ::: "memory");
            const unsigned og = xb_add(&bar[XB_TOP], 1u);
            const unsigned tg = og / nx;
            if (og + 1u == (tg + 1u) * nx) xb_add(&bar[XB_TOPGEN], 1u);
            else XB_SPIN(xb_ld(&bar[XB_TOPGEN]) == tg, bar);
            __builtin_amdgcn_fence(__ATOMIC_ACQUIRE, "agent");
            xb_add(&bar[XB_XGEN(b.x)], 1u);
            asm volatile("s_waitcnt vmcnt(0)" ::: "memory");
        } else {
            XB_SPIN(xb_ld(&bar[XB_XGEN(b.x)]) == gen, bar);
            __builtin_amdgcn_fence(__ATOMIC_ACQUIRE, "agent");
            asm volatile("s_waitcnt vmcnt(0)" ::: "memory");
        }
    }
    __syncthreads();
}

struct Params { const float* in[19]; float* out; unsigned char* ws; float inv_freq[32]; };
constexpr int LDS_BYTES = 131072 + 512;

__device__ __forceinline__ float wave_sum(float v) {
#pragma unroll
    for (int o = 1; o < 64; o <<= 1) v += __shfl_xor(v, o);
    return v;
}
__device__ __forceinline__ int src_col(int kind, int n) {
    if (kind == 0) { if (n < 1920) return n; if (n < 1984) { const int j = n - 1920; return 1920 + (j & 1) * 32 + (j >> 1); } return -1; }
    if (kind == 1) { const int hh = n / 192, d = n % 192; if (d < 128) return n; const int j = d - 128; return 192 * hh + 128 + (j & 1) * 32 + (j >> 1); }
    return n;
}
__device__ __forceinline__ void transpose_item(const float* W, int K, int N, bf16_t* WT, int kind, const float* gain, LAS float* scr, int item, int nblk, int lane) {
    const int kb = item / nblk, nb = item % nblk, k0 = 64 * kb, n0 = 32 * nb;
    const int src = src_col(kind, n0 + (lane & 31));
    const float cs = (kind == 0 && n0 < 512) ? C2_DA : 1.0f;
#pragma unroll 8
    for (int i = 0; i < 32; ++i) { const int kk = 2 * i + (lane >> 5); float v = 0.f; if (src >= 0) v = W[(size_t)(k0 + kk) * N + src]; if (gain) v *= gain[k0 + kk]; scr[kk * 33 + (lane & 31)] = v * cs; }
    asm volatile("s_waitcnt lgkmcnt(0)" ::: "memory");
    const int c = lane & 7;
#pragma unroll
    for (int j = 0; j < 4; ++j) { const int n = (lane >> 3) + 8 * j; const LAS float* s = scr + (8 * c) * 33 + n;
        u32x4 o; o.x = pg8::cvt_pk_bf16(s[0 * 33], s[1 * 33]); o.y = pg8::cvt_pk_bf16(s[2 * 33], s[3 * 33]); o.z = pg8::cvt_pk_bf16(s[4 * 33], s[5 * 33]); o.w = pg8::cvt_pk_bf16(s[6 * 33], s[7 * 33]);
        *(u32x4*)(WT + (size_t)(n0 + n) * K + k0 + 8 * c) = o; }
    asm volatile("s_waitcnt lgkmcnt(0)" ::: "memory");
}

__global__ void __launch_bounds__(512, 2) fwd_megakernel(Params P) {
    extern __shared__ __attribute__((aligned(16))) unsigned char lds_raw[];
    LAS unsigned char* lds = (LAS unsigned char*)lds_raw;
    cg::grid_group grid = cg::this_grid();
    const int tid = threadIdx.x, lane = tid & 63, wave = __builtin_amdgcn_readfirstlane(tid >> 6);
    const int G = gridDim.x, bx = blockIdx.x;
    int vcu = (G % 8 == 0) ? (bx % 8) * (G / 8) + bx / 8 : bx;
    int cid = bx;
#define XIN (P.in[0])
#define RQ ((float*)(P.ws + WS_STAT))
#define RKV (RQ + MALL)
#define SS1 (RQ + 2 * MALL)
#define SS2 (RQ + 3 * MALL)
#define TAB ((float*)(P.ws + WS_TAB))
#define WIN ((bf16_t*)(P.ws + WS_WIN))
#define WQ ((bf16_t*)(P.ws + WS_WQ))
#define WKV ((bf16_t*)(P.ws + WS_WKV))
#define WO ((bf16_t*)(P.ws + WS_WO))
#define W1 ((bf16_t*)(P.ws + WS_W1))
#define W2 ((bf16_t*)(P.ws + WS_W2))
#define U ((bf16_t*)(P.ws + WS_U))
#define MIX ((bf16_t*)(P.ws + WS_MIX))
#define MIXO ((bf16_t*)(P.ws + WS_MIXO))
#define PROJ ((bf16_t*)(P.ws + WS_PROJ))
#define KD ((bf16_t*)(P.ws + WS_KD))
#define VD ((bf16_t*)(P.ws + WS_VD))
#define QM ((bf16_t*)(P.ws + WS_QM))
#define KN ((bf16_t*)(P.ws + WS_KN))
#define VM ((bf16_t*)(P.ws + WS_VM))
#define KR ((bf16_t*)(P.ws + WS_KR))
#define HB ((bf16_t*)(P.ws + WS_H))
#define FB MIX
    const int NGW = G * 8;
    int gw = vcu * 8 + wave;
    unsigned* ctl = (unsigned*)(P.ws + WS_CTL);
    LAS unsigned* misc = (LAS unsigned*)(lds + 131072);
    const unsigned xcc = (unsigned)__builtin_amdgcn_s_getreg((3 << 11) | 20) & 7u;
    if (tid == 0) { misc[16] = 0u; misc[17] = 0u; }
    __syncthreads();
    const XcdBarrier xbar = xcd_barrier_post((unsigned*)(P.ws + WS_BAR), (volatile LAS unsigned*)(misc + 16));
    if (tid == 0) misc[0] = __hip_atomic_fetch_add(ctl + 16 * xcc, 1u, __ATOMIC_RELAXED, __HIP_MEMORY_SCOPE_AGENT);

#if (PH >> 0) & 1
    {
        LAS float* scr = (LAS float*)(lds + wave * 16384);
        constexpr int I_IN = 16 * 64, I_Q = 4 * 24, I_KV = 2 * 32, I_O = 16 * 32, I_1 = 16 * 128, I_2 = 64 * 32;
        constexpr int NITEMS = I_IN + I_Q + I_KV + I_O + I_1 + I_2;
        for (int it = gw; it < NITEMS; it += NGW) {
            int r = it;
            if (r < I_IN) { transpose_item(P.in[3], 1024, 1984, WIN, 0, nullptr, scr, r, 64, lane); continue; } r -= I_IN;
            if (r < I_Q) { transpose_item(P.in[10], 256, 768, WQ, 1, P.in[9], scr, r, 24, lane); continue; } r -= I_Q;
            if (r < I_KV) { transpose_item(P.in[12], 128, 1024, WKV, 2, P.in[11], scr, r, 32, lane); continue; } r -= I_KV;
            if (r < I_O) { transpose_item(P.in[13], 1024, 1024, WO, 2, nullptr, scr, r, 32, lane); continue; } r -= I_O;
            if (r < I_1) { transpose_item(P.in[16], 1024, 4096, W1, 2, nullptr, scr, r, 128, lane); continue; } r -= I_1;
            transpose_item(P.in[17], 4096, 1024, W2, 2, nullptr, scr, r, 32, lane);
        }
        f32x4 gp[4];
#pragma unroll
        for (int j = 0; j < 4; ++j) gp[j] = *(const f32x4*)(P.in[2] + 4 * lane + 256 * j);
        for (int m = gw; m < MALL; m += NGW) {
            unsigned long long* o8 = (unsigned long long*)(U + (size_t)m * 1024) + lane;
            if (m >= MX + N_META) {
#pragma unroll
                for (int j = 0; j < 4; ++j) o8[64 * j] = 0ull;
                continue; }
            const float* src = (m < MX) ? XIN + (size_t)m * 1024 : P.in[1] + (size_t)(m - MX) * 1024;
            f32x4 v[4]; float s = 0.f;
#pragma unroll
            for (int j = 0; j < 4; ++j) { v[j] = *(const f32x4*)(src + 4 * lane + 256 * j); s += (v[j][0] * v[j][0] + v[j][1] * v[j][1]) + (v[j][2] * v[j][2] + v[j][3] * v[j][3]); }
            const float rs = rsqrtf(wave_sum(s) * (1.0f / 1024.0f) + EPS);
#pragma unroll
            for (int j = 0; j < 4; ++j) { const f32x4 y = v[j] * rs * gp[j];
                o8[64 * j] = (unsigned long long)pg8::cvt_pk_bf16(y[0], y[1]) | ((unsigned long long)pg8::cvt_pk_bf16(y[2], y[3]) << 32); }
        }
        const int gt = vcu * 512 + tid, NGT = G * 512;
        for (int i = gt; i < 4 * MALL; i += NGT) RQ[i] = 0.f;
        for (int i = gt; i < LTOT * 32; i += NGT) {
            const int pos = i >> 5, fi = i & 31;
            const float ang = (float)pos * P.inv_freq[fi];
            const double a = (double)ang; const double k = rint(a * 0.6366197723675814); const double r = fma(-k, 1.5707963267948966, a) - k * 6.123233995736766e-17;
            const double r2 = r * r;
            double sn = r * (1.0 + r2 * (-1.0 / 6 + r2 * (1.0 / 120 + r2 * (-1.0 / 5040 + r2 * (1.0 / 362880 + r2 * (-1.0 / 39916800 + r2 * (1.0 / 6227020800.0)))))));
            double cs = 1.0 + r2 * (-0.5 + r2 * (1.0 / 24 + r2 * (-1.0 / 720 + r2 * (1.0 / 40320 + r2 * (-1.0 / 3628800 + r2 * (1.0 / 479001600.0))))));
            const int qd = ((int)k) & 3;
            double c_, s_;
            if (qd == 0) { c_ = cs; s_ = sn; } else if (qd == 1) { c_ = -sn; s_ = cs; } else if (qd == 2) { c_ = -cs; s_ = -sn; } else { c_ = sn; s_ = -cs; }
            TAB[2 * i] = (float)c_; TAB[2 * i + 1] = (float)s_;
        }
    }
#endif
    grid.sync();
    if (tid == 0) { unsigned base = 0, n[8];
#pragma unroll
        for (int j = 0; j < 8; ++j) n[j] = __hip_atomic_load(ctl + 16 * j, __ATOMIC_RELAXED, __HIP_MEMORY_SCOPE_AGENT);
#pragma unroll
        for (int j = 0; j < 8; ++j) if ((unsigned)j < xcc) base += n[j];
        misc[1] = base + misc[0]; }
    __syncthreads();
    if (G == 256) { vcu = __builtin_amdgcn_readfirstlane((int)misc[1]); cid = (vcu & 31) * 8 + (vcu >> 5); gw = vcu * 8 + wave; }

#if (PH >> 1) & 1
    {
        pg8::Gemm g{U, WIN, MALL, NPROJ, 1024, 1024}; pg8::StaticOrder S; S.init(MALL, NPROJ, G, cid);
        pg8::EpiIn E{PROJ, KD, VD, KR, RQ, RKV, TAB, ctl + 128};
        pg8::gemm_phase<pg8::EpiIn, pg8::StaticOrder, true, true>(lds, g, S, E);
    }
#endif
    xcd_barrier(xbar);

#if (PH >> 2) & 1
    {
        pg8::Gemm g{PROJ + 512, WQ, MX, 768, 256, PPITCH}; pg8::StaticOrder S; S.init(MX, 768, G, cid);
        pg8::EpiQ E{QM, RQ, TAB};
        pg8::gemm_phase<pg8::EpiQ, pg8::StaticOrder, true, true>(lds, g, S, E);
    }
    {
        pg8::Gemm g{PROJ + 768, WKV, MALL, 1024, 128, PPITCH}; pg8::StaticOrder S; S.init(MALL, 1024, G, (cid + 128) % G);
        pg8::EpiKV E{KN, VM, RKV};
        pg8::gemm_phase<pg8::EpiKV, pg8::StaticOrder, true, true>(lds, g, S, E);
    }
#endif
    xcd_barrier(xbar);

#if (PH >> 3) & 1
    {
        float a = P.in[4][lane] * P.in[5][lane], c = P.in[6][lane] * P.in[7][lane];
        a = wave_sum(a); c = wave_sum(c);
        const float lam = expf(a) - expf(c) + 0.2f;
        const att::Tensors T{PROJ, KD, VD, QM, KN, VM, KR, MIX, P.in[8], ctl + 128};
        if (G == 256) {
            const int b = vcu >> 5, i = vcu & 31;
            for (int j = 0; j < 6; ++j) {
                if (j == 2) att::attn_unit<false>(lds, T, b, i < 16 ? 0 : 1, i & 15, 0.f);
                else if (j == 5) att::attn_unit<false>(lds, T, b, i < 16 ? 2 : 3, 15 - (i & 15), 0.f);
                else { const int hh = j < 2 ? j : j - 1; att::attn_unit<true>(lds, T, b, hh, (hh == 0 || hh == 3) ? i : 31 - i, lam); }
            }
        }
    }
#endif
    xcd_barrier(xbar);

#if (PH >> 4) & 1
    {
        pg8::Gemm g{MIX, WO, MX, 1024, 1024, 1024}; pg8::StaticOrder S; S.init(MX, 1024, G, cid);
        pg8::EpiSS E{MIXO, 1024, SS1};
        pg8::gemm_phase<pg8::EpiSS, pg8::StaticOrder, true, true>(lds, g, S, E);
    }
#endif
    xcd_barrier(xbar);

#if (PH >> 5) & 1
    {
        f32x4 g1[4], g2[4];
#pragma unroll
        for (int j = 0; j < 4; ++j) { g1[j] = *(const f32x4*)(P.in[14] + 4 * lane + 256 * j); g2[j] = *(const f32x4*)(P.in[15] + 4 * lane + 256 * j); }
        for (int m = gw; m < MX; m += NGW) {
            const float r1 = rsqrtf(SS1[m] * (1.0f / 1024.0f) + EPS);
            const unsigned long long* mi = (const unsigned long long*)(MIXO + (size_t)m * 1024) + lane;
            f32x4 hv[4]; float s = 0.f;
#pragma unroll
            for (int j = 0; j < 4; ++j) { const f32x4 xv = *(const f32x4*)(XIN + (size_t)m * 1024 + 4 * lane + 256 * j); const unsigned long long w = mi[64 * j];
                f32x4 mv; mv[0] = __uint_as_float((unsigned)(w & 0xffffu) << 16); mv[1] = __uint_as_float((unsigned)w & 0xffff0000u); mv[2] = __uint_as_float((unsigned)((w >> 32) & 0xffffu) << 16); mv[3] = __uint_as_float((unsigned)(w >> 32) & 0xffff0000u);
                hv[j] = xv + mv * r1 * g1[j]; s += (hv[j][0] * hv[j][0] + hv[j][1] * hv[j][1]) + (hv[j][2] * hv[j][2] + hv[j][3] * hv[j][3]);
                *(f32x4*)(P.out + (size_t)m * 1024 + 4 * lane + 256 * j) = hv[j]; }
            const float rs = rsqrtf(wave_sum(s) * (1.0f / 1024.0f) + EPS);
            unsigned long long* o8 = (unsigned long long*)(U + (size_t)m * 1024) + lane;
#pragma unroll
            for (int j = 0; j < 4; ++j) { const f32x4 y = hv[j] * rs * g2[j];
                o8[64 * j] = (unsigned long long)pg8::cvt_pk_bf16(y[0], y[1]) | ((unsigned long long)pg8::cvt_pk_bf16(y[2], y[3]) << 32); }
        }
    }
#endif
    xcd_barrier(xbar);

#if (PH >> 6) & 1
    {
        pg8::Gemm g{U, W1, MX, D_FF, 1024, 1024}; pg8::StaticOrder S; S.init(MX, D_FF, G, cid);
        pg8::EpiRelu2 E{HB, D_FF};
        pg8::gemm_phase<pg8::EpiRelu2, pg8::StaticOrder, true, true>(lds, g, S, E);
    }
#endif
    xcd_barrier(xbar);

#if (PH >> 7) & 1
    {
        pg8::Gemm g{HB, W2, MX, 1024, D_FF, D_FF}; pg8::StaticOrder S; S.init(MX, 1024, G, cid);
        pg8::EpiSS E{FB, 1024, SS2};
        pg8::gemm_phase<pg8::EpiSS, pg8::StaticOrder, true, true>(lds, g, S, E);
    }
#endif
    xcd_barrier(xbar);

#if (PH >> 8) & 1
    {
        f32x4 g3[4];
#pragma unroll
        for (int j = 0; j < 4; ++j) g3[j] = *(const f32x4*)(P.in[18] + 4 * lane + 256 * j);
        for (int m = gw; m < MX; m += NGW) {
            const float r2 = rsqrtf(SS2[m] * (1.0f / 1024.0f) + EPS);
            const unsigned long long* fi = (const unsigned long long*)(FB + (size_t)m * 1024) + lane;
#pragma unroll
            for (int j = 0; j < 4; ++j) { float* op = P.out + (size_t)m * 1024 + 4 * lane + 256 * j; const f32x4 hv = *(const f32x4*)op; const unsigned long long w = fi[64 * j];
                f32x4 mv; mv[0] = __uint_as_float((unsigned)(w & 0xffffu) << 16); mv[1] = __uint_as_float((unsigned)w & 0xffff0000u); mv[2] = __uint_as_float((unsigned)((w >> 32) & 0xffffu) << 16); mv[3] = __uint_as_float((unsigned)(w >> 32) & 0xffff0000u);
                *(f32x4*)op = hv + mv * r2 * g3[j]; }
        }
    }
#endif
}

extern "C" void kernel_launch(void* const* d_in, const int* in_sizes, int n_in, void* d_out, int out_size, void* d_ws, size_t ws_size, hipStream_t stream) {
    static int grid = 0;
    if (grid == 0) {
        if (n_in != 19 || in_sizes[0] != MX * D_MODEL || out_size != MX * D_MODEL || ws_size < WS_END) {
            fprintf(stderr, "kernel_launch: unexpected shapes (n_in %d, in0 %d, out %d, ws %zu); nothing launched\n", n_in, n_in > 0 ? in_sizes[0] : -1, out_size, ws_size); grid = -1; return; }
        int dev = 0, cus = 0, per_cu = 0;
        hipGetDevice(&dev);
        hipDeviceGetAttribute(&cus, hipDeviceAttributeMultiprocessorCount, dev);
        if (hipFuncSetAttribute((const void*)fwd_megakernel, hipFuncAttributeMaxDynamicSharedMemorySize, LDS_BYTES) != hipSuccess) { fprintf(stderr, "kernel_launch: hipFuncSetAttribute failed\n"); grid = -1; return; }
        if (hipOccupancyMaxActiveBlocksPerMultiprocessor(&per_cu, (const void*)fwd_megakernel, 512, LDS_BYTES) != hipSuccess || per_cu < 1) { fprintf(stderr, "kernel_launch: occupancy query failed (%d)\n", per_cu); grid = -1; return; }
        grid = cus;
        fprintf(stderr, "kernel_launch: cus %d per_cu %d grid %d\n", cus, per_cu, grid);
    }
    if (grid < 0) return;
    Params p{};
    for (int i = 0; i < 19; ++i) p.in[i] = (const float*)d_in[i];
    p.out = (float*)d_out; p.ws = (unsigned char*)d_ws;
    for (int i = 0; i < 32; ++i) p.inv_freq[i] = 1.0f / powf(10000.0f, (float)(2 * i) / 64.0f);
    if (hipMemsetAsync((char*)d_ws + WS_CTL, 0, 32768, stream) != hipSuccess) { fprintf(stderr, "kernel_launch: memset failed\n"); return; }
    void* args[] = {&p};
    hipError_t e = hipLaunchCooperativeKernel((const void*)fwd_megakernel, dim3(grid), dim3(512), args, LDS_BYTES, stream);
    if (e != hipSuccess) fprintf(stderr, "cooperative launch failed: %s (grid %d)\n", hipGetErrorString(e), grid);
}
```

```cpp
#ifndef PH
#define PH 0x1ff
#endif
#include <hip/hip_runtime.h>
#include <hip/hip_cooperative_groups.h>
#include <cstdio>
#include <cstdint>
#include <cmath>
namespace cg = cooperative_groups;

#define LAS __attribute__((address_space(3)))
typedef unsigned short bf16_t;
typedef short bf16x8 __attribute__((ext_vector_type(8)));
typedef float f32x4 __attribute__((ext_vector_type(4)));
typedef float f32x2 __attribute__((ext_vector_type(2)));
typedef float f32x16 __attribute__((ext_vector_type(16)));
typedef unsigned u32x4 __attribute__((ext_vector_type(4)));
typedef unsigned u32x2 __attribute__((ext_vector_type(2)));
typedef __bf16 bf16x2_t __attribute__((ext_vector_type(2)));
typedef short v4i16_t __attribute__((ext_vector_type(4)));

constexpr int D_MODEL = 1024, BATCH = 8, SEQ = 4096, N_META = 16, LTOT = SEQ + N_META;
constexpr int MX = BATCH * SEQ;
constexpr int MALL = MX + 256;
constexpr int NPROJ = 2048;
constexpr int PPITCH = 1024;
constexpr int D_FF = 4096;
constexpr float EPS = 1e-6f;
constexpr float LOG2E = 1.4426950408889634f;
constexpr float C2_DA = 0.125f * LOG2E;
constexpr float C2_MLA = 0.07216878364870322f * LOG2E;

constexpr size_t MiB = 1u << 20;
constexpr size_t WS_STAT = 0;
constexpr size_t WS_TAB = 1 * MiB;
constexpr size_t WS_CTL = 3 * MiB;
constexpr size_t WS_BAR = 3 * MiB + 16384;
constexpr size_t WS_WIN = 4 * MiB;
constexpr size_t WS_WQ = 8 * MiB;
constexpr size_t WS_WKV = 9 * MiB;
constexpr size_t WS_WO = 10 * MiB;
constexpr size_t WS_W1 = 12 * MiB;
constexpr size_t WS_W2 = 20 * MiB;
constexpr size_t WS_U = 32 * MiB;
constexpr size_t WS_MIX = 100 * MiB;
constexpr size_t WS_MIXO = 164 * MiB;
constexpr size_t WS_PROJ = 228 * MiB;
constexpr size_t WS_KD = 293 * MiB;
constexpr size_t WS_VD = 326 * MiB;
constexpr size_t WS_QM = 359 * MiB;
constexpr size_t WS_KN = 408 * MiB;
constexpr size_t WS_VM = 441 * MiB;
constexpr size_t WS_KR = 474 * MiB;
constexpr size_t WS_H = 228 * MiB;
constexpr size_t WS_END = 484 * MiB;

namespace pg8 {
constexpr int BM = 256, BK = 64, HALF = 128, HTB = HALF * BK * 2, STAGE_BYTES = 8 * HTB, NXCD = 8, WGM = 8;
__host__ __device__ __forceinline__ int lds_byte(int r, int c) { const int st = (r >> 4) * 2 + (c >> 5), rr = r & 15, cc = c & 31, ob = rr * 64 + cc * 2; return st * 1024 + (ob ^ (((ob >> 9) & 1) << 5)); }
__host__ __device__ __forceinline__ void stage_rc(int b, int& R, int& C) { const int st = b / 1024, sb = b % 1024, swz = sb ^ (((sb >> 9) & 1) << 5); R = (st >> 1) * 16 + swz / 64; C = (st & 1) * 32 + (swz % 64) / 2; }
__host__ __device__ __forceinline__ int perm32(int rho) { const int n = rho >> 4, i = rho & 15; return 8 * (i >> 2) + 4 * n + (i & 3); }
struct Unit { int pm, pn; };
struct Gemm { const bf16_t* A; const bf16_t* Bt; int M, N, K, lda; };
struct StaticOrder {
    int nM, nN, nwg, G, c;
    __host__ __device__ void init(int M, int N, int G_, int c_) { nM = M / BM; nN = N / BM; nwg = nM * nN; G = G_; c = c_; }
    __host__ __device__ bool next(int i, Unit& u) const {
        const long L = (long)i * G + c; if (L >= nwg) return false;
        int wgid = (int)L; { const int q = nwg / NXCD, r = nwg % NXCD, xcd = wgid % NXCD, off = wgid / NXCD; wgid = (xcd < r ? xcd * (q + 1) : r * (q + 1) + (xcd - r) * q) + off; }
        const int nig = WGM * nN, gid = wgid / nig, fm = gid * WGM, gsz = (nM - fm) < WGM ? (nM - fm) : WGM;
        u.pm = fm + ((wgid % nig) % gsz); u.pn = (wgid % nig) / gsz; return true;
    }
    __device__ __forceinline__ void a_ready(const Unit&) const {}
    __device__ __forceinline__ void done(const Unit&) const {}
};
__device__ __forceinline__ unsigned cvt_pk_bf16(float lo, float hi) { f32x2 v = {lo, hi}; bf16x2_t b = __builtin_convertvector(v, bf16x2_t); return __builtin_bit_cast(unsigned, b); }
__device__ __forceinline__ u32x4 pack8(const f32x4& v0, const f32x4& v1) { u32x4 w; w.x = cvt_pk_bf16(v0[0], v0[1]); w.y = cvt_pk_bf16(v0[2], v0[3]); w.z = cvt_pk_bf16(v1[0], v1[1]); w.w = cvt_pk_bf16(v1[2], v1[3]); return w; }
__device__ __forceinline__ float ssq8(const f32x4& a, const f32x4& b) { return (a[0] * a[0] + a[1] * a[1]) + (a[2] * a[2] + a[3] * a[3]) + (b[0] * b[0] + b[1] * b[1]) + (b[2] * b[2] + b[3] * b[3]); }
__device__ __forceinline__ void rope8(f32x4& v0, f32x4& v1, const float* tab, int pos, int i0) {
    const f32x4 t0 = *(const f32x4*)(tab + ((size_t)pos * 32 + i0) * 2), t1 = *(const f32x4*)(tab + ((size_t)pos * 32 + i0 + 2) * 2);
    f32x4 a, b;
    a[0] = v0[0] * t0[0] - v0[1] * t0[1]; a[1] = v0[1] * t0[0] + v0[0] * t0[1];
    a[2] = v0[2] * t0[2] - v0[3] * t0[3]; a[3] = v0[3] * t0[2] + v0[2] * t0[3];
    b[0] = v1[0] * t1[0] - v1[1] * t1[1]; b[1] = v1[1] * t1[0] + v1[0] * t1[1];
    b[2] = v1[2] * t1[2] - v1[3] * t1[3]; b[3] = v1[3] * t1[2] + v1[2] * t1[3];
    v0 = a; v1 = b;
}

struct EpiIn {
    static constexpr bool PERM = true, AFTER_DRAIN = false;
    bf16_t* PROJ; bf16_t* KD; bf16_t* VD; bf16_t* KR; float* RQ; float* RKV; const float* tab; unsigned* kmax;
    __device__ __forceinline__ void operator()(const f32x4 (&acc)[2][2][4][2], const Unit& u, int wr, int wc, int fr, int fq) const {
        const int row0 = u.pm * BM + wr * 64 + fr, cw = wc * 32 + 8 * fq, pn = u.pn;
        const bool kt = pn == 2 || pn == 3; float km0 = 0.f, km1 = 0.f;
        bf16_t* base0; bf16_t* base1; int pitch0, pitch1;
        if (pn < 2) { base0 = PROJ + pn * BM; base1 = base0 + HALF; pitch0 = pitch1 = PPITCH; }
        else if (pn < 6) { base0 = (pn < 4 ? KD : VD) + (size_t)((pn & 1) * 2) * MALL * 128; base1 = base0 + (size_t)MALL * 128; pitch0 = pitch1 = 128; }
        else if (pn == 6) { base0 = PROJ + 512; base1 = base0 + HALF; pitch0 = pitch1 = PPITCH; }
        else { base0 = PROJ + 768; pitch0 = PPITCH; base1 = KR; pitch1 = 64; }
        const bool stat = pn >= 6, kr = pn == 7;
#pragma unroll
        for (int ai = 0; ai < 2; ++ai)
#pragma unroll
            for (int m = 0; m < 4; ++m) {
                const int row = row0 + ai * HALF + m * 16;
                { const f32x4 v0 = acc[ai][0][m][0], v1 = acc[ai][0][m][1]; *(u32x4*)(base0 + (size_t)row * pitch0 + cw) = pack8(v0, v1);
                  f32x4 w0 = acc[ai][1][m][0], w1 = acc[ai][1][m][1];
                  if (kr) { if (wc < 2) { const int pos = row < MX ? N_META + (row & (SEQ - 1)) : ((row - MX) < N_META ? (row - MX) : 0);
                                rope8(w0, w1, tab, pos, 16 * wc + 4 * fq); *(u32x4*)(base1 + (size_t)row * pitch1 + cw) = pack8(w0, w1); } }
                  else *(u32x4*)(base1 + (size_t)row * pitch1 + cw) = pack8(w0, w1);
                  if (kt) { float s0 = ssq8(v0, v1), s1 = ssq8(w0, w1); s0 += __shfl_xor(s0, 16); s0 += __shfl_xor(s0, 32); s1 += __shfl_xor(s1, 16); s1 += __shfl_xor(s1, 32); km0 = fmaxf(km0, s0); km1 = fmaxf(km1, s1); }
                  if (stat) { float ss = ssq8(v0, v1); if (!kr) ss += ssq8(w0, w1);
                      ss += __shfl_xor(ss, 16); ss += __shfl_xor(ss, 32);
                      if (fq == 0) __hip_atomic_fetch_add((kr ? RKV : RQ) + row, ss, __ATOMIC_RELAXED, __HIP_MEMORY_SCOPE_AGENT); } }
                asm volatile("" ::: "memory");
            }
        if (kt) {
#pragma unroll
            for (int o = 1; o < 16; o <<= 1) { km0 = fmaxf(km0, __shfl_xor(km0, o)); km1 = fmaxf(km1, __shfl_xor(km1, o)); }
            if (fr == 0 && fq == 0) { const int h0 = (pn & 1) * 2;
                __hip_atomic_fetch_max(kmax + 2 * (2 * h0 + (wc >> 1)) + (wc & 1), __float_as_uint(km0), __ATOMIC_RELAXED, __HIP_MEMORY_SCOPE_AGENT);
                __hip_atomic_fetch_max(kmax + 2 * (2 * (h0 + 1) + (wc >> 1)) + (wc & 1), __float_as_uint(km1), __ATOMIC_RELAXED, __HIP_MEMORY_SCOPE_AGENT); }
        }
    }
};
struct EpiQ {
    static constexpr bool PERM = true, AFTER_DRAIN = false;
    bf16_t* QM; const float* RQ; const float* tab;
    __device__ __forceinline__ void operator()(const f32x4 (&acc)[2][2][4][2], const Unit& u, int wr, int wc, int fr, int fq) const {
        const int row0 = u.pm * BM + wr * 64 + fr, colt = u.pn * BM + wc * 32 + 8 * fq;
        const int blk0 = (8 * u.pn + wc) % 6, blk1 = (8 * u.pn + 4 + wc) % 6;
#pragma unroll
        for (int ai = 0; ai < 2; ++ai)
#pragma unroll
            for (int m = 0; m < 4; ++m) {
                const int row = row0 + ai * HALF + m * 16; const float sc = rsqrtf(RQ[row] * (1.0f / 256.0f) + EPS) * C2_MLA; const int pos = N_META + (row & (SEQ - 1));
                { f32x4 v0 = acc[ai][0][m][0] * sc, v1 = acc[ai][0][m][1] * sc;
                  if (blk0 >= 4) rope8(v0, v1, tab, pos, (blk0 - 4) * 16 + 4 * fq);
                  *(u32x4*)(QM + (size_t)row * 768 + colt) = pack8(v0, v1); }
                { f32x4 v0 = acc[ai][1][m][0] * sc, v1 = acc[ai][1][m][1] * sc;
                  if (blk1 >= 4) rope8(v0, v1, tab, pos, (blk1 - 4) * 16 + 4 * fq);
                  *(u32x4*)(QM + (size_t)row * 768 + colt + HALF) = pack8(v0, v1); }
                asm volatile("" ::: "memory");
            }
    }
};
struct EpiKV {
    static constexpr bool PERM = true, AFTER_DRAIN = false;
    bf16_t* KN; bf16_t* VM; const float* RKV;
    __device__ __forceinline__ void operator()(const f32x4 (&acc)[2][2][4][2], const Unit& u, int wr, int wc, int fr, int fq) const {
        const int row0 = u.pm * BM + wr * 64 + fr, c0 = wc * 32 + 8 * fq;
#pragma unroll
        for (int ai = 0; ai < 2; ++ai)
#pragma unroll
            for (int m = 0; m < 4; ++m) {
                const int row = row0 + ai * HALF + m * 16; const float sc = rsqrtf(RKV[row] * (1.0f / 128.0f) + EPS);
                *(u32x4*)(KN + ((size_t)u.pn * MALL + row) * 128 + c0) = pack8(acc[ai][0][m][0] * sc, acc[ai][0][m][1] * sc);
                *(u32x4*)(VM + ((size_t)u.pn * MALL + row) * 128 + c0) = pack8(acc[ai][1][m][0] * sc, acc[ai][1][m][1] * sc);
                asm volatile("" ::: "memory");
            }
    }
};
struct EpiSS {
    static constexpr bool PERM = true, AFTER_DRAIN = false;
    bf16_t* O; int ldc; float* SS;
    __device__ __forceinline__ void operator()(const f32x4 (&acc)[2][2][4][2], const Unit& u, int wr, int wc, int fr, int fq) const {
        const int row0 = u.pm * BM + wr * 64 + fr, colt = u.pn * BM + wc * 32 + 8 * fq;
#pragma unroll
        for (int ai = 0; ai < 2; ++ai)
#pragma unroll
            for (int m = 0; m < 4; ++m) {
                const int row = row0 + ai * HALF + m * 16; float ss = 0.f;
#pragma unroll
                for (int bj = 0; bj < 2; ++bj) { const f32x4 v0 = acc[ai][bj][m][0], v1 = acc[ai][bj][m][1];
                    *(u32x4*)(O + (size_t)row * ldc + colt + bj * HALF) = pack8(v0, v1); ss += ssq8(v0, v1); }
                ss += __shfl_xor(ss, 16); ss += __shfl_xor(ss, 32);
                if (fq == 0) __hip_atomic_fetch_add(SS + row, ss, __ATOMIC_RELAXED, __HIP_MEMORY_SCOPE_AGENT);
            }
    }
};
struct EpiRelu2 {
    static constexpr bool PERM = true, AFTER_DRAIN = false;
    bf16_t* O; int ldc;
    __device__ __forceinline__ void operator()(const f32x4 (&acc)[2][2][4][2], const Unit& u, int wr, int wc, int fr, int fq) const {
        const int row0 = u.pm * BM + wr * 64 + fr, colt = u.pn * BM + wc * 32 + 8 * fq;
#pragma unroll
        for (int ai = 0; ai < 2; ++ai)
#pragma unroll
            for (int m = 0; m < 4; ++m) {
                const int row = row0 + ai * HALF + m * 16;
#pragma unroll
                for (int bj = 0; bj < 2; ++bj) { f32x4 v0 = acc[ai][bj][m][0], v1 = acc[ai][bj][m][1];
#pragma unroll
                    for (int e = 0; e < 4; ++e) { const float a = fmaxf(v0[e], 0.f), b = fmaxf(v1[e], 0.f); v0[e] = a * a; v1[e] = b * b; }
                    *(u32x4*)(O + (size_t)row * ldc + colt + bj * HALF) = pack8(v0, v1); }
            }
    }
};

template <class Epi, class Sched, bool ALIGN_EPI = false, bool SP2 = false>
__device__ __forceinline__ void gemm_phase(LAS unsigned char* lds, const Gemm g, const Sched& S, const Epi& E) {
    int tid_ = threadIdx.x; asm volatile("" : "+v"(tid_));
    const int tid = tid_, wid = __builtin_amdgcn_readfirstlane(tid >> 6), lane = tid & 63, wr = wid >> 2, wc = wid & 3, fr = lane & 15, fq = lane >> 4;
    int K_ = g.K; asm volatile("" : "+s"(K_));
    const int K = K_, nt = K / BK, lda = g.lda;
    unsigned voffA[2], voffB[2];
#pragma unroll
    for (int i = 0; i < 2; ++i) { int R, C; stage_rc(tid * 16 + i * 8192, R, C); const int Rb = Epi::PERM ? ((R & ~31) + perm32(R & 31)) : R;
        voffA[i] = (unsigned)(R * lda + C) * 2u; voffB[i] = (unsigned)(Rb * K + C) * 2u; }
    const size_t kstep = (size_t)(BK * 2);
    const size_t hstepA = (size_t)HALF * lda * 2, hstepB = (size_t)HALF * K * 2;
    const size_t tstepA = 2 * hstepA, tstepB = 2 * hstepB;
    const unsigned ldsw = (unsigned)wid * 1024u;
    const int aoff = lds_byte(wr * 64 + fr, fq * 8), boff = lds_byte(wc * 32 + fr, fq * 8);
#define PG8_SA(b, h) (((b) * 2 + (h)) * HTB)
#define PG8_SB(b, h) ((4 + (b) * 2 + (h)) * HTB)
#define PG8_STAGE(bufoff, gbase, voff) do { _Pragma("unroll") for (int _i = 0; _i < 2; ++_i) \
        __builtin_amdgcn_global_load_lds((const unsigned*)((const char*)(gbase) + (voff)[_i]), (LAS unsigned*)(lds + (bufoff) + ldsw + _i * 8192), 16, 0, 0); } while (0)
#define PG8_LDA(dst, b, h) do { _Pragma("unroll") for (int m = 0; m < 4; ++m) _Pragma("unroll") for (int k = 0; k < 2; ++k) dst[m][k] = *(const LAS bf16x8*)(lds + PG8_SA(b, h) + aoff + m * 2048 + k * 1024); } while (0)
#define PG8_LDB(dst, b, h) do { _Pragma("unroll") for (int n = 0; n < 2; ++n) _Pragma("unroll") for (int k = 0; k < 2; ++k) dst[n][k] = *(const LAS bf16x8*)(lds + PG8_SB(b, h) + boff + n * 2048 + k * 1024); } while (0)
#define PG8_MMA(ai, bj, At, Bt) do { __builtin_amdgcn_s_setprio(1); _Pragma("unroll") for (int m = 0; m < 4; ++m) _Pragma("unroll") for (int n = 0; n < 2; ++n) _Pragma("unroll") for (int k = 0; k < 2; ++k) \
        acc[ai][bj][m][n] = __builtin_amdgcn_mfma_f32_16x16x32_bf16(Bt[n][k], At[m][k], acc[ai][bj][m][n], 0, 0, 0); __builtin_amdgcn_s_setprio(0); } while (0)
#define PG8_WAIT_V(n) asm volatile("s_waitcnt vmcnt(" #n ")" ::: "memory")
#define PG8_WAIT_L(n) asm volatile("s_waitcnt lgkmcnt(" #n ")" ::: "memory")
#define PG8_BAR __builtin_amdgcn_s_barrier()
#define PG8_SCHED __builtin_amdgcn_sched_barrier(0)
    Unit cur, nxt; int ui = 0;
    if (!S.next(0, cur)) return;
    f32x4 acc[2][2][4][2];
#pragma unroll
    for (int a = 0; a < 2; ++a)
#pragma unroll
        for (int b = 0; b < 2; ++b)
#pragma unroll
            for (int m = 0; m < 4; ++m)
#pragma unroll
                for (int n = 0; n < 2; ++n) acc[a][b][m][n] = (f32x4){0.f, 0.f, 0.f, 0.f};
    bf16x8 At[4][2], B0[2][2], B1[2][2];
    const char* cA = (const char*)g.A + (size_t)cur.pm * tstepA; const char* cB = (const char*)g.Bt + (size_t)cur.pn * tstepB;
    S.a_ready(cur);
    if constexpr (SP2) {
        PG8_STAGE(PG8_SB(0, 0), cB, voffB); PG8_STAGE(PG8_SB(0, 1), cB + hstepB, voffB); PG8_STAGE(PG8_SA(0, 0), cA, voffA); PG8_STAGE(PG8_SA(0, 1), cA + hstepA, voffA);
        if (wr == 1) PG8_BAR;
        PG8_WAIT_V(2); PG8_BAR;
        PG8_STAGE(PG8_SB(1, 0), cB + kstep, voffB); PG8_STAGE(PG8_SA(1, 0), cA + kstep, voffA); PG8_STAGE(PG8_SB(1, 1), cB + hstepB + kstep, voffB);
        PG8_WAIT_V(6); PG8_BAR;
    } else {
        PG8_STAGE(PG8_SB(0, 0), cB, voffB); PG8_STAGE(PG8_SA(0, 0), cA, voffA); PG8_STAGE(PG8_SB(0, 1), cB + hstepB, voffB); PG8_STAGE(PG8_SA(0, 1), cA + hstepA, voffA);
        if (wr == 1) PG8_BAR;
        PG8_WAIT_V(4); PG8_BAR;
        PG8_STAGE(PG8_SB(1, 0), cB + kstep, voffB); PG8_STAGE(PG8_SA(1, 0), cA + kstep, voffA); PG8_STAGE(PG8_SB(1, 1), cB + hstepB + kstep, voffB);
        PG8_WAIT_V(6); PG8_BAR;
    }
    for (;;) {
        const bool has_next = S.next(ui + 1, nxt);
        const char* nA = has_next ? (const char*)g.A + (size_t)nxt.pm * tstepA : cA; const char* nB = has_next ? (const char*)g.Bt + (size_t)nxt.pn * tstepB : cB;
#pragma clang loop unroll(disable)
        for (int t = 0; t < nt; t += 2) {
            const bool last = (t == nt - 2);
            const char* a1 = cA + (size_t)(t + 1) * kstep;
            const char* a2 = last ? nA : cA + (size_t)(t + 2) * kstep; const char* b2 = last ? nB : cB + (size_t)(t + 2) * kstep;
            const char* a3 = a2 + kstep; const char* b3 = b2 + kstep;
            if (last && has_next) S.a_ready(nxt);
            if constexpr (SP2) {
            PG8_LDB(B0, 0, 0); PG8_LDB(B1, 0, 1); PG8_SCHED; PG8_LDA(At, 0, 0); PG8_STAGE(PG8_SA(1, 1), a1 + hstepA, voffA);
            PG8_WAIT_V(8); PG8_WAIT_L(0); PG8_BAR; PG8_MMA(0, 0, At, B0); PG8_MMA(0, 1, At, B1); PG8_BAR; PG8_SCHED;
            PG8_LDA(At, 0, 1); PG8_STAGE(PG8_SB(0, 0), b2, voffB); PG8_STAGE(PG8_SB(0, 1), b2 + hstepB, voffB); PG8_STAGE(PG8_SA(0, 0), a2, voffA);
            PG8_WAIT_V(8); PG8_WAIT_L(0); PG8_BAR; PG8_MMA(1, 0, At, B0); PG8_MMA(1, 1, At, B1); PG8_BAR; PG8_SCHED;
            PG8_LDB(B0, 1, 0); PG8_LDB(B1, 1, 1); PG8_SCHED; PG8_LDA(At, 1, 0); PG8_STAGE(PG8_SA(0, 1), a2 + hstepA, voffA);
            PG8_WAIT_V(8); PG8_WAIT_L(0); PG8_BAR; PG8_MMA(0, 0, At, B0); PG8_MMA(0, 1, At, B1); PG8_BAR; PG8_SCHED;
            PG8_LDA(At, 1, 1); PG8_STAGE(PG8_SB(1, 0), b3, voffB); PG8_STAGE(PG8_SB(1, 1), b3 + hstepB, voffB); PG8_STAGE(PG8_SA(1, 0), a3, voffA);
            PG8_WAIT_V(8); PG8_WAIT_L(0); PG8_BAR; PG8_MMA(1, 0, At, B0); PG8_MMA(1, 1, At, B1); PG8_BAR; PG8_SCHED;
            } else {
            PG8_LDB(B0, 0, 0); PG8_SCHED; PG8_LDA(At, 0, 0); PG8_STAGE(PG8_SA(1, 1), a1 + hstepA, voffA);
            PG8_WAIT_L(8); PG8_BAR; PG8_WAIT_L(0); PG8_MMA(0, 0, At, B0); PG8_BAR; PG8_SCHED;
            PG8_LDB(B1, 0, 1); PG8_STAGE(PG8_SB(0, 0), b2, voffB);
            PG8_BAR; PG8_WAIT_L(0); PG8_MMA(0, 1, At, B1); PG8_BAR;
            PG8_LDA(At, 0, 1); PG8_STAGE(PG8_SA(0, 0), a2, voffA);
            PG8_BAR; PG8_WAIT_L(0); PG8_MMA(1, 0, At, B0); PG8_BAR; PG8_SCHED;
            PG8_STAGE(PG8_SB(0, 1), b2 + hstepB, voffB);
            PG8_WAIT_V(6); PG8_BAR; PG8_MMA(1, 1, At, B1); PG8_BAR;
            PG8_LDB(B0, 1, 0); PG8_SCHED; PG8_LDA(At, 1, 0); PG8_STAGE(PG8_SA(0, 1), a2 + hstepA, voffA);
            PG8_WAIT_L(8); PG8_BAR; PG8_WAIT_L(0); PG8_MMA(0, 0, At, B0); PG8_BAR; PG8_SCHED;
            PG8_LDB(B1, 1, 1); PG8_STAGE(PG8_SB(1, 0), b3, voffB);
            PG8_BAR; PG8_WAIT_L(0); PG8_MMA(0, 1, At, B1); PG8_BAR;
            PG8_LDA(At, 1, 1); PG8_STAGE(PG8_SA(1, 0), a3, voffA);
            PG8_BAR; PG8_WAIT_L(0); PG8_MMA(1, 0, At, B0); PG8_BAR; PG8_SCHED;
            PG8_STAGE(PG8_SB(1, 1), b3 + hstepB, voffB);
            PG8_WAIT_V(6); PG8_BAR; PG8_MMA(1, 1, At, B1); PG8_BAR;
            }
        }
        if constexpr (ALIGN_EPI) { if (wr == 0) PG8_BAR; }
        if constexpr (!Epi::AFTER_DRAIN) { E(acc, cur, wr, wc, fr, fq); S.done(cur); }
        if (!has_next) break;
#pragma unroll
        for (int a = 0; a < 2; ++a)
#pragma unroll
            for (int b = 0; b < 2; ++b)
#pragma unroll
                for (int m = 0; m < 4; ++m)
#pragma unroll
                    for (int n = 0; n < 2; ++n) acc[a][b][m][n] = (f32x4){0.f, 0.f, 0.f, 0.f};
        cur = nxt; cA = nA; cB = nB; ++ui;
        if constexpr (ALIGN_EPI) { if (wr == 1) PG8_BAR; }
    }
    PG8_WAIT_V(0);
    if constexpr (!ALIGN_EPI) { if (wr == 0) PG8_BAR; }
    PG8_BAR;
#undef PG8_SA
#undef PG8_SB
#undef PG8_STAGE
#undef PG8_LDA
#undef PG8_LDB
#undef PG8_MMA
#undef PG8_WAIT_V
#undef PG8_WAIT_L
#undef PG8_BAR
#undef PG8_SCHED
}
}

namespace att {
constexpr int VOFF = 26624, BUFB = 43008, NPIECE = 42;
constexpr int KP_DA = 144, KCOMP_DA = 64 * KP_DA;
constexpr int KNP = 272, KR_OFF = 64 * KNP, KRP = 144;
struct Tensors { const bf16_t* PROJ; const bf16_t* KD; const bf16_t* VD; const bf16_t* QM; const bf16_t* KN; const bf16_t* VM; const bf16_t* KR; bf16_t* MIX; const float* gsub; const unsigned* kmax; };
__device__ __forceinline__ float swap_max(float v) { auto rr = __builtin_amdgcn_permlane32_swap(__float_as_uint(v), __float_as_uint(v), false, false); return fmaxf(__uint_as_float(rr[0]), __uint_as_float(rr[1])); }
__device__ __forceinline__ float swap_sum(float v) { auto rr = __builtin_amdgcn_permlane32_swap(__float_as_uint(v), __float_as_uint(v), false, false); return __uint_as_float(rr[0]) + __uint_as_float(rr[1]); }
__device__ __forceinline__ unsigned off_b(unsigned row, unsigned ch) { return 256u * row + 16u * (ch ^ (((row & 3) << 2) | ((row >> 2) & 3))); }
__device__ __forceinline__ unsigned tr_read_addr(unsigned lane, unsigned c, unsigned ks, unsigned t) {
    const unsigned h = lane >> 5, blk = (lane >> 4) & 1, q = (lane & 15) >> 2, p = lane & 3;
    return off_b(16 * ks + 8 * h + 4 * t + q, 4 * c + 2 * blk + (p >> 1)) + 8 * (p & 1);
}
__device__ __forceinline__ bf16x8 pack_p(const f32x16& p, int o) {
    u32x4 w; w.x = pg8::cvt_pk_bf16(p[o + 0], p[o + 1]); w.y = pg8::cvt_pk_bf16(p[o + 2], p[o + 3]); w.z = pg8::cvt_pk_bf16(p[o + 4], p[o + 5]); w.w = pg8::cvt_pk_bf16(p[o + 6], p[o + 7]);
    return __builtin_bit_cast(bf16x8, w);
}

__device__ __forceinline__ void glds16(const void* gsrc, unsigned lds_dst) { unsigned keep;
    asm volatile("s_mov_b32 %0, m0\n\ts_mov_b32 m0, %2\n\ts_nop 0\n\tglobal_load_lds_dwordx4 %1, off\n\ts_mov_b32 m0, %0" : "=&s"(keep) : "v"(gsrc), "s"(lds_dst) : "memory"); }
#define ATT_WAITBAR(N) asm volatile("s_waitcnt vmcnt(" #N ") lgkmcnt(0)\n\ts_barrier" ::: "memory")
__device__ __forceinline__ float mx3(float a, float b, float c) { return __builtin_fmaxf(__builtin_fmaxf(a, b), c); }
template <bool DA>
__device__ __forceinline__ void attn_unit(LAS unsigned char* lds, const Tensors& T, int b, int h, int u, float lam) {
    int tid_ = threadIdx.x; asm volatile("" : "+v"(tid_));
    const int tid = tid_, lane = tid & 63, q32 = lane & 31, hi = lane >> 5;
    const int wid = __builtin_amdgcn_readfirstlane(tid >> 6);
    const int comp = DA ? (wid >> 2) : 0, wq = DA ? (wid & 3) : wid;
    unsigned voff[6];
#pragma unroll
    for (int i = 0; i < 6; ++i) {
        const unsigned pi = wid + 8 * i, o = pi * 1024 + lane * 16; unsigned v = 0;
        if (o < (unsigned)VOFF) {
            if (DA) { const unsigned cp = o / KCOMP_DA, rem = o - cp * KCOMP_DA, key = rem / KP_DA; unsigned cc = (rem - key * KP_DA) >> 4; if (cc == 8) cc = 0; v = (key & 63) * 256 + (cp & 1) * 128 + cc * 16; }
            else if (o < (unsigned)KR_OFF) { const unsigned key = o / KNP; unsigned cc = (o - key * KNP) >> 4; if (cc == 16) cc = 0; v = key * 256 + cc * 16; }
            else { const unsigned o2 = o - KR_OFF, key = o2 / KRP; unsigned cc = (o2 - key * KRP) >> 4; if (cc == 8) cc = 0; v = (key & 63) * 128 + cc * 16; }
        } else {
            const unsigned ov = o - VOFF, img = (ov >> 13) & 1, slot = (ov & 8191) >> 4, rho = slot >> 4, chp = slot & 15;
            const unsigned ch = chp ^ (((rho & 3) << 2) | ((rho >> 2) & 3)), kk = (rho & ~12u) | ((rho & 4) << 1) | ((rho & 8) >> 1), key = 32 * img + kk;
            v = key * 256 + ch * 16;
        }
        voff[i] = v;
    }
    const unsigned lds0 = (unsigned)(size_t)lds;
    const int npiece = DA ? (wid < 2 ? 5 : 4) : (wid < 2 ? 6 : 5);
    constexpr int QPU = DA ? 128 : 256, CPU = QPU / 64;
    const int NT = CPU * u + CPU + 1;
    const int tmax = CPU * u + (wq >> 1) + 1;
    auto issue = [&](int tt, int bufoff) {
        const size_t row0 = (tt == 0) ? (size_t)MX : (size_t)b * SEQ + (size_t)(tt - 1) * 64;
        const char *pK, *pK2, *pV;
        const size_t hrow = ((size_t)h * MALL + row0) * 256;
        if (DA) { pK = (const char*)T.KD + hrow; pK2 = pK; pV = (const char*)T.VD + hrow; }
        else { pK = (const char*)T.KN + hrow; pK2 = (const char*)T.KR + row0 * 128; pV = (const char*)T.VM + hrow; }
#pragma unroll
        for (int i = 0; i < 6; ++i) {
            const int pi = wid + 8 * i;
            if (pi >= NPIECE) continue;
            if (DA && pi >= 18 && pi < 26) continue;
            const char* base = (pi >= 26) ? pV : ((!DA && pi >= 17) ? pK2 : pK);
            glds16(base + voff[i], (unsigned)__builtin_amdgcn_readfirstlane((int)(lds0 + bufoff + pi * 1024)));
        }
    };
    issue(NT - 1, 0); issue(NT - 2, BUFB);
    const int qx = u * QPU + wq * 32 + q32;
    const size_t qrow = (size_t)b * SEQ + qx;
    constexpr int NQF = DA ? 4 : 12;
    bf16x8 qf[NQF];
    if (DA) { const bf16_t* qp = T.PROJ + qrow * PPITCH + 128 * h + 64 * comp + 8 * hi;
#pragma unroll
        for (int s = 0; s < 4; ++s) qf[s] = *(const bf16x8*)(qp + 16 * s); }
    else { const bf16_t* qp = T.QM + qrow * 768 + 192 * h + 8 * hi;
#pragma unroll
        for (int s = 0; s < 12; ++s) qf[s] = *(const bf16x8*)(qp + 16 * s); }
#pragma unroll
    for (int s = 0; s < NQF; ++s) asm volatile("" : "+v"(qf[s]));
    float qbound = 0.f;
    LAS unsigned* vote = (LAS unsigned*)(lds + 131072) + 8;
    if (DA) {
        float ss = 0.f;
#pragma unroll
        for (int s = 0; s < 4; ++s)
#pragma unroll
            for (int e = 0; e < 8; ++e) { const float v = __uint_as_float(((unsigned)(unsigned short)qf[s][e]) << 16); ss += v * v; }
        ss = swap_sum(ss);
        const float km = __uint_as_float(__hip_atomic_load(T.kmax + 2 * (2 * h + comp), __ATOMIC_RELAXED, __HIP_MEMORY_SCOPE_AGENT)) + __uint_as_float(__hip_atomic_load(T.kmax + 2 * (2 * h + comp) + 1, __ATOMIC_RELAXED, __HIP_MEMORY_SCOPE_AGENT));
        qbound = sqrtf(ss * km) * 1.01f;
        if (tid < 3) vote[tid] = 0u;
    }
    bool wdone = false; int vi = 0;
    f32x16 O[4]; float mrun = -1e30f, lrun = 0.f;
#pragma unroll
    for (int cc = 0; cc < 4; ++cc)
#pragma unroll
        for (int r = 0; r < 16; ++r) O[cc][r] = 0.f;
    const float slope2 = DA ? exp2f(-2.0f * (float)(h + 1)) * LOG2E : 0.f;
    const float H64 = 64.0f * slope2, H32 = 32.0f * slope2;
    f32x16 cvec;
#pragma unroll
    for (int r = 0; r < 16; ++r) cvec[r] = DA ? slope2 * (float)((r & 3) + 8 * (r >> 2) + 4 * hi) : 0.f;
    unsigned vad[4][2];
#pragma unroll
    for (int cc = 0; cc < 4; ++cc)
#pragma unroll
        for (int t = 0; t < 2; ++t) vad[cc][t] = tr_read_addr(lane, cc, 0, t);
    if (npiece == 6) ATT_WAITBAR(6); else if (npiece == 5) ATT_WAITBAR(5); else ATT_WAITBAR(4);

    int bo0 = 0, bo1 = BUFB, bo2 = 2 * BUFB;
    for (int tt = NT - 1; tt >= 0; --tt) {
        if (tt >= 2) issue(tt - 2, bo2);
        if (tt <= tmax) {
            LAS unsigned char* kb = lds + bo0;
            LAS unsigned char* vb = kb + VOFF;
            f32x16 p0, p1;
#define ATT_VFRAG(dst, cc_, kap_) do { const v4i16_t lo_ = __builtin_amdgcn_ds_read_tr16_b64_v4i16((LAS v4i16_t*)(vb + vad[cc_][0] + ((kap_) & 1) * 4096 + ((kap_) >> 1) * 8192)); \
                const v4i16_t hh_ = __builtin_amdgcn_ds_read_tr16_b64_v4i16((LAS v4i16_t*)(vb + vad[cc_][1] + ((kap_) & 1) * 4096 + ((kap_) >> 1) * 8192)); \
                dst = (bf16x8){lo_[0], lo_[1], lo_[2], lo_[3], hh_[0], hh_[1], hh_[2], hh_[3]}; } while (0)
#define ATT_SB() __builtin_amdgcn_sched_barrier(0)
            bf16x8 va[4], vbf[4];
            if (DA) {
                mrun += H64;
                LAS unsigned char* kp = kb + comp * KCOMP_DA + q32 * KP_DA + hi * 16;
                bf16x8 kf[8];
#pragma unroll
                for (int s = 0; s < 4; ++s) { kf[2 * s] = *(const LAS bf16x8*)(kp + 32 * s); kf[2 * s + 1] = *(const LAS bf16x8*)(kp + 32 * KP_DA + 32 * s); }
                ATT_SB();
                p0 = __builtin_amdgcn_mfma_f32_32x32x16_bf16(kf[0], qf[0], cvec, 0, 0, 0); p1 = __builtin_amdgcn_mfma_f32_32x32x16_bf16(kf[1], qf[0], cvec, 0, 0, 0);
#pragma unroll
                for (int s = 1; s < 4; ++s) { p0 = __builtin_amdgcn_mfma_f32_32x32x16_bf16(kf[2 * s], qf[s], p0, 0, 0, 0); p1 = __builtin_amdgcn_mfma_f32_32x32x16_bf16(kf[2 * s + 1], qf[s], p1, 0, 0, 0); }
                ATT_SB();
            } else {
                const f32x16 z16 = {0.f, 0.f, 0.f, 0.f, 0.f, 0.f, 0.f, 0.f, 0.f, 0.f, 0.f, 0.f, 0.f, 0.f, 0.f, 0.f};
                LAS unsigned char* kp = kb + q32 * KNP + hi * 16;
                LAS unsigned char* kp2 = kb + KR_OFF + q32 * KRP + hi * 16;
                bf16x8 kA[4], kB[4];
#define ATT_KADDR(s_) ((s_) < 8 ? kp + 32 * (s_) : kp2 + 32 * ((s_) - 8))
#define ATT_KLOAD(dst, j_) do { dst[0] = *(const LAS bf16x8*)(ATT_KADDR(2 * (j_))); dst[1] = *(const LAS bf16x8*)(ATT_KADDR(2 * (j_)) + ((j_) < 4 ? 32 * KNP : 32 * KRP)); \
                dst[2] = *(const LAS bf16x8*)(ATT_KADDR(2 * (j_) + 1)); dst[3] = *(const LAS bf16x8*)(ATT_KADDR(2 * (j_) + 1) + ((j_) < 4 ? 32 * KNP : 32 * KRP)); } while (0)
#define ATT_KMM(src, j_) do { p0 = __builtin_amdgcn_mfma_f32_32x32x16_bf16(src[0], qf[2 * (j_)], p0, 0, 0, 0); p1 = __builtin_amdgcn_mfma_f32_32x32x16_bf16(src[1], qf[2 * (j_)], p1, 0, 0, 0); \
                p0 = __builtin_amdgcn_mfma_f32_32x32x16_bf16(src[2], qf[2 * (j_) + 1], p0, 0, 0, 0); p1 = __builtin_amdgcn_mfma_f32_32x32x16_bf16(src[3], qf[2 * (j_) + 1], p1, 0, 0, 0); } while (0)
                ATT_KLOAD(kA, 0); ATT_KLOAD(kB, 1); ATT_SB();
                p0 = z16; p1 = z16;
                ATT_KMM(kA, 0); ATT_SB(); ATT_KLOAD(kA, 2); ATT_SB();
                ATT_KMM(kB, 1); ATT_SB(); ATT_KLOAD(kB, 3); ATT_SB();
                ATT_KMM(kA, 2); ATT_SB(); ATT_KLOAD(kA, 4); ATT_SB();
                ATT_KMM(kB, 3); ATT_SB(); ATT_KLOAD(kB, 5); ATT_SB();
                ATT_KMM(kA, 4); ATT_SB(); ATT_KMM(kB, 5); ATT_SB();
            }
            float off0 = 0.f, off1 = 0.f;
            if (DA) {
                off1 = H32;
                if (tt == 0) off0 = 48.0f * slope2;
                if (tt == tmax) {
                    const float qoff = (float)(qx - 64 * (tt - 1)), dq = qoff - (float)(4 * hi);
#pragma unroll
                    for (int r = 0; r < 16; ++r) { const float cr = (float)((r & 3) + 8 * (r >> 2));
                        p0[r] = (p0[r] - cvec[r]) - slope2 * fabsf(dq - cr); p1[r] = (p1[r] - cvec[r]) - slope2 * fabsf(dq - 32.0f - cr); }
                    off0 = slope2 * qoff; off1 = off0;
                }
            }
            if (tt == 0) {
#pragma unroll
                for (int r = 0; r < 16; ++r) { if (r >= 8) p0[r] = -1e30f; p1[r] = -1e30f; }
            }
            float ra = mx3(p0[0], p0[1], p0[2]), rb = mx3(p1[0], p1[1], p1[2]);
            ra = mx3(ra, p0[3], p0[4]); rb = mx3(rb, p1[3], p1[4]);
#pragma unroll
            for (int r = 5; r < 15; r += 2) { ra = mx3(ra, p0[r], p0[r + 1]); rb = mx3(rb, p1[r], p1[r + 1]); }
            ra = fmaxf(ra, p0[15]); rb = fmaxf(rb, p1[15]);
            const float rm = swap_max(fmaxf(ra + off0, rb + off1));
            const bool skip = DA && __all(rm - mrun < -40.0f);
            if (!skip) {
                const float mn = fmaxf(mrun, rm), alpha = __builtin_amdgcn_exp2f(mrun - mn);
                mrun = mn;
                const float m0 = mn - off0, m1 = mn - off1;
                float sum = 0.f;
#pragma unroll
                for (int r = 0; r < 16; ++r) { p0[r] = __builtin_amdgcn_exp2f(p0[r] - m0); p1[r] = __builtin_amdgcn_exp2f(p1[r] - m1); sum += p0[r] + p1[r]; }
                ATT_SB();
#pragma unroll
                for (int cc = 0; cc < 4; ++cc) ATT_VFRAG(va[cc], cc, 0);
                ATT_SB();
                lrun = lrun * alpha + sum;
                if (__any(alpha != 1.0f)) {
#pragma unroll
                    for (int cc = 0; cc < 4; ++cc)
#pragma unroll
                        for (int r = 0; r < 16; ++r) O[cc][r] *= alpha;
                }
                bf16x8 pf[4]; pf[0] = pack_p(p0, 0); pf[1] = pack_p(p0, 8); pf[2] = pack_p(p1, 0); pf[3] = pack_p(p1, 8);
#define ATT_PVMM(src, kap_) do { _Pragma("unroll") for (int cc = 0; cc < 4; ++cc) O[cc] = __builtin_amdgcn_mfma_f32_32x32x16_bf16(src[cc], pf[kap_], O[cc], 0, 0, 0); } while (0)
#define ATT_PVLD(dst, kap_) do { _Pragma("unroll") for (int cc = 0; cc < 4; ++cc) ATT_VFRAG(dst[cc], cc, kap_); } while (0)
                ATT_SB(); ATT_PVLD(vbf, 1); ATT_SB();
                ATT_PVMM(va, 0); ATT_SB(); ATT_PVLD(va, 2); ATT_SB();
                ATT_PVMM(vbf, 1); ATT_SB(); ATT_PVLD(vbf, 3); ATT_SB();
                ATT_PVMM(va, 2); ATT_SB(); ATT_PVMM(vbf, 3); ATT_SB();
            }
        }
        if (DA) {
            if (tt <= tmax && !wdone) wdone = __all(qbound + 63.0f * slope2 - (mrun + H64) < -40.0f);
            const int vn = vi == 2 ? 0 : vi + 1;
            if (tid == 0) vote[vn] = 0u;
            if (wdone && lane == 0) __hip_atomic_fetch_add(vote + vi, 1u, __ATOMIC_RELAXED, __HIP_MEMORY_SCOPE_WORKGROUP);
        }
        if (tt >= 2) { if (npiece == 6) ATT_WAITBAR(6); else if (npiece == 5) ATT_WAITBAR(5); else ATT_WAITBAR(4); }
        else ATT_WAITBAR(0);
        { const int t_ = bo0; bo0 = bo1; bo1 = bo2; bo2 = t_; }
        if (DA) {
            const unsigned nv = *(volatile LAS unsigned*)(vote + vi);
            vi = vi == 2 ? 0 : vi + 1;
            if (nv == 8u && tt > 0) { ATT_WAITBAR(0); break; }
        }
    }
    if (DA) {
        LAS float* xch = (LAS float*)lds + (size_t)wq * 64 * 64 + lane;
        const float i1 = (comp ? lam : 1.0f) / swap_sum(lrun);
        if (comp == 1) {
#pragma unroll
            for (int cc = 0; cc < 4; ++cc)
#pragma unroll
                for (int r = 0; r < 16; ++r) xch[(cc * 16 + r) * 64] = O[cc][r] * i1;
        }
        __syncthreads();
        if (comp == 0) {
            float ss = 0.f;
#pragma unroll
            for (int cc = 0; cc < 4; ++cc)
#pragma unroll
                for (int r = 0; r < 16; ++r) { const float o = O[cc][r] * i1 - xch[(cc * 16 + r) * 64]; O[cc][r] = o; ss += o * o; if ((r & 7) == 7) asm volatile("" ::: "memory"); }
            ss = swap_sum(ss);
            const float rn = rsqrtf(ss * (1.0f / 128.0f) + EPS) * 0.8f;
            bf16_t* op = T.MIX + qrow * 1024 + 128 * h + 4 * hi;
#pragma unroll
            for (int cc = 0; cc < 4; ++cc)
#pragma unroll
                for (int g = 0; g < 4; ++g) { const f32x4 gs = *(const f32x4*)(T.gsub + 32 * cc + 8 * g + 4 * hi);
                    u32x2 w; w.x = pg8::cvt_pk_bf16(O[cc][4 * g] * rn * gs[0], O[cc][4 * g + 1] * rn * gs[1]); w.y = pg8::cvt_pk_bf16(O[cc][4 * g + 2] * rn * gs[2], O[cc][4 * g + 3] * rn * gs[3]);
                    *(u32x2*)(op + 32 * cc + 8 * g) = w; asm volatile("" ::: "memory"); }
        }
        __syncthreads();
    } else {
        const float i1 = 1.0f / swap_sum(lrun);
        bf16_t* op = T.MIX + qrow * 1024 + 512 + 128 * h + 4 * hi;
#pragma unroll
        for (int cc = 0; cc < 4; ++cc)
#pragma unroll
            for (int g = 0; g < 4; ++g) { u32x2 w; w.x = pg8::cvt_pk_bf16(O[cc][4 * g] * i1, O[cc][4 * g + 1] * i1); w.y = pg8::cvt_pk_bf16(O[cc][4 * g + 2] * i1, O[cc][4 * g + 3] * i1);
                *(u32x2*)(op + 32 * cc + 8 * g) = w; }
    }
}
}

#define XB_TMO      128
#define XB_XCNT(j)  (256  + 64 * (j))
#define XB_XSUB(j)  (1280 + 64 * (j))
#define XB_XGEN(j)  (2304 + 64 * (j))
#define XB_TOP      3328
#define XB_TOPGEN   3392
#define XCD_BAR_WORDS 3456
#define XB_SPIN_CAP (1u << 18)
__device__ __forceinline__ unsigned xb_ld(unsigned* p)              { return __hip_atomic_load(p, __ATOMIC_RELAXED, __HIP_MEMORY_SCOPE_AGENT); }
__device__ __forceinline__ unsigned xb_add(unsigned* p, unsigned v) { return __hip_atomic_fetch_add(p, v, __ATOMIC_RELAXED, __HIP_MEMORY_SCOPE_AGENT); }
__device__ __forceinline__ unsigned xb_xcc_id() { return (unsigned)__builtin_amdgcn_s_getreg((3 << 11) | 20) & 0xFu; }
#define XB_SPIN(cond, bar) do { unsigned _sp = 0; while (cond) { __builtin_amdgcn_s_sleep(1); \
    if ((++_sp & 255u) == 0u) { if (xb_ld(&(bar)[XB_TMO])) break; if (_sp > XB_SPIN_CAP) { atomicAdd(&(bar)[XB_TMO], 1u); break; } } } } while (0)
struct XcdBarrier { unsigned* bar; unsigned x; volatile LAS unsigned* st; };
__device__ __forceinline__ XcdBarrier xcd_barrier_post(unsigned* bar, volatile LAS unsigned* st) {
    XcdBarrier b; b.bar = bar; b.x = xb_xcc_id(); b.st = st;
    if (threadIdx.x == 0) (void)xb_add(&bar[XB_XCNT(b.x)], 1u);
    return b;
}
__device__ __forceinline__ void xcd_barrier_complete(unsigned* bar, unsigned x, unsigned& nloc, unsigned& nx) {
    const unsigned G = gridDim.x * gridDim.y * gridDim.z;
    unsigned sum, cnt, mine, sp = 0u;
    for (;;) {
        sum = 0u; cnt = 0u; mine = 0u;
#pragma unroll
        for (unsigned j = 0; j < 16; ++j) { const unsigned c = xb_ld(&bar[XB_XCNT(j)]); sum += c; cnt += (c > 0u) ? 1u : 0u; mine = (j == x) ? c : mine; }
        if (sum == G) break;
        __builtin_amdgcn_s_sleep(1);
        if ((++sp & 255u) == 0u) { if (xb_ld(&bar[XB_TMO])) break; if (sp > XB_SPIN_CAP) { atomicAdd(&bar[XB_TMO], 1u); break; } }
    }
    nloc = mine > 0u ? mine : 1u; nx = cnt > 0u ? cnt : 1u;
}
__device__ __forceinline__ void xcd_barrier(const XcdBarrier& b) {
    asm volatile("s_waitcnt vmcnt(0)" ::: "memory");
    __syncthreads();
    if (threadIdx.x == 0) {
        unsigned* bar = b.bar;
        __builtin_amdgcn_s_waitcnt(0);
        unsigned nloc = b.st[0], nx = b.st[1];
        if (nloc == 0u) { xcd_barrier_complete(bar, b.x, nloc, nx); b.st[0] = nloc; b.st[1] = nx; }
        const unsigned old = xb_add(&bar[XB_XSUB(b.x)], 1u);
        const unsigned gen = old / nloc;
        if (old + 1u == (gen + 1u) * nloc) {
            __builtin_amdgcn_fence(__ATOMIC_RELEASE, "agent");
            asm volatile("s_waitcnt vmcnt(0)" ::: "memory");
            const unsigned og = xb_add(&bar[XB_TOP], 1u);
            const unsigned tg = og / nx;
            if (og + 1u == (tg + 1u) * nx) xb_add(&bar[XB_TOPGEN], 1u);
            else XB_SPIN(xb_ld(&bar[XB_TOPGEN]) == tg, bar);
            __builtin_amdgcn_fence(__ATOMIC_ACQUIRE, "agent");
            xb_add(&bar[XB_XGEN(b.x)], 1u);
            asm volatile("s_waitcnt vmcnt(0)" ::: "memory");
        } else {
            XB_SPIN(xb_ld(&bar[XB_XGEN(b.x)]) == gen, bar);
            __builtin_amdgcn_fence(__ATOMIC_ACQUIRE, "agent");
            asm volatile("s_waitcnt vmcnt(0)" ::: "memory");
        }
    }
    __syncthreads();
}

struct Params { const float* in[19]; float* out; unsigned char* ws; float inv_freq[32]; };
constexpr int LDS_BYTES = 131072 + 512;

__device__ __forceinline__ float wave_sum(float v) {
#pragma unroll
    for (int o = 1; o < 64; o <<= 1) v += __shfl_xor(v, o);
    return v;
}
__device__ __forceinline__ int src_col(int kind, int n) {
    if (kind == 0) { if (n < 1920) return n; if (n < 1984) { const int j = n - 1920; return 1920 + (j & 1) * 32 + (j >> 1); } return -1; }
    if (kind == 1) { const int hh = n / 192, d = n % 192; if (d < 128) return n; const int j = d - 128; return 192 * hh + 128 + (j & 1) * 32 + (j >> 1); }
    return n;
}
__device__ __forceinline__ void transpose_item(const float* W, int K, int N, bf16_t* WT, int kind, const float* gain, LAS float* scr, int item, int nblk, int lane) {
    const int kb = item / nblk, nb = item % nblk, k0 = 64 * kb, n0 = 32 * nb;
    const int src = src_col(kind, n0 + (lane & 31));
    const float cs = (kind == 0 && n0 < 512) ? C2_DA : 1.0f;
#pragma unroll 8
    for (int i = 0; i < 32; ++i) { const int kk = 2 * i + (lane >> 5); float v = 0.f; if (src >= 0) v = W[(size_t)(k0 + kk) * N + src]; if (gain) v *= gain[k0 + kk]; scr[kk * 33 + (lane & 31)] = v * cs; }
    asm volatile("s_waitcnt lgkmcnt(0)" ::: "memory");
    const int c = lane & 7;
#pragma unroll
    for (int j = 0; j < 4; ++j) { const int n = (lane >> 3) + 8 * j; const LAS float* s = scr + (8 * c) * 33 + n;
        u32x4 o; o.x = pg8::cvt_pk_bf16(s[0 * 33], s[1 * 33]); o.y = pg8::cvt_pk_bf16(s[2 * 33], s[3 * 33]); o.z = pg8::cvt_pk_bf16(s[4 * 33], s[5 * 33]); o.w = pg8::cvt_pk_bf16(s[6 * 33], s[7 * 33]);
        *(u32x4*)(WT + (size_t)(n0 + n) * K + k0 + 8 * c) = o; }
    asm volatile("s_waitcnt lgkmcnt(0)" ::: "memory");
}

__global__ void __launch_bounds__(512, 2) fwd_megakernel(Params P) {
    extern __shared__ __attribute__((aligned(16))) unsigned char lds_raw[];
    LAS unsigned char* lds = (LAS unsigned char*)lds_raw;
    cg::grid_group grid = cg::this_grid();
    const int tid = threadIdx.x, lane = tid & 63, wave = __builtin_amdgcn_readfirstlane(tid >> 6);
    const int G = gridDim.x, bx = blockIdx.x;
    int vcu = (G % 8 == 0) ? (bx % 8) * (G / 8) + bx / 8 : bx;
    int cid = bx;
#define XIN (P.in[0])
#define RQ ((float*)(P.ws + WS_STAT))
#define RKV (RQ + MALL)
#define SS1 (RQ + 2 * MALL)
#define SS2 (RQ + 3 * MALL)
#define TAB ((float*)(P.ws + WS_TAB))
#define WIN ((bf16_t*)(P.ws + WS_WIN))
#define WQ ((bf16_t*)(P.ws + WS_WQ))
#define WKV ((bf16_t*)(P.ws + WS_WKV))
#define WO ((bf16_t*)(P.ws + WS_WO))
#define W1 ((bf16_t*)(P.ws + WS_W1))
#define W2 ((bf16_t*)(P.ws + WS_W2))
#define U ((bf16_t*)(P.ws + WS_U))
#define MIX ((bf16_t*)(P.ws + WS_MIX))
#define MIXO ((bf16_t*)(P.ws + WS_MIXO))
#define PROJ ((bf16_t*)(P.ws + WS_PROJ))
#define KD ((bf16_t*)(P.ws + WS_KD))
#define VD ((bf16_t*)(P.ws + WS_VD))
#define QM ((bf16_t*)(P.ws + WS_QM))
#define KN ((bf16_t*)(P.ws + WS_KN))
#define VM ((bf16_t*)(P.ws + WS_VM))
#define KR ((bf16_t*)(P.ws + WS_KR))
#define HB ((bf16_t*)(P.ws + WS_H))
#define FB MIX
    const int NGW = G * 8;
    int gw = vcu * 8 + wave;
    unsigned* ctl = (unsigned*)(P.ws + WS_CTL);
    LAS unsigned* misc = (LAS unsigned*)(lds + 131072);
    const unsigned xcc = (unsigned)__builtin_amdgcn_s_getreg((3 << 11) | 20) & 7u;
    if (tid == 0) { misc[16] = 0u; misc[17] = 0u; }
    __syncthreads();
    const XcdBarrier xbar = xcd_barrier_post((unsigned*)(P.ws + WS_BAR), (volatile LAS unsigned*)(misc + 16));
    if (tid == 0) misc[0] = __hip_atomic_fetch_add(ctl + 16 * xcc, 1u, __ATOMIC_RELAXED, __HIP_MEMORY_SCOPE_AGENT);

#if (PH >> 0) & 1
    {
        LAS float* scr = (LAS float*)(lds + wave * 16384);
        constexpr int I_IN = 16 * 64, I_Q = 4 * 24, I_KV = 2 * 32, I_O = 16 * 32, I_1 = 16 * 128, I_2 = 64 * 32;
        constexpr int NITEMS = I_IN + I_Q + I_KV + I_O + I_1 + I_2;
        for (int it = gw; it < NITEMS; it += NGW) {
            int r = it;
            if (r < I_IN) { transpose_item(P.in[3], 1024, 1984, WIN, 0, nullptr, scr, r, 64, lane); continue; } r -= I_IN;
            if (r < I_Q) { transpose_item(P.in[10], 256, 768, WQ, 1, P.in[9], scr, r, 24, lane); continue; } r -= I_Q;
            if (r < I_KV) { transpose_item(P.in[12], 128, 1024, WKV, 2, P.in[11], scr, r, 32, lane); continue; } r -= I_KV;
            if (r < I_O) { transpose_item(P.in[13], 1024, 1024, WO, 2, nullptr, scr, r, 32, lane); continue; } r -= I_O;
            if (r < I_1) { transpose_item(P.in[16], 1024, 4096, W1, 2, nullptr, scr, r, 128, lane); continue; } r -= I_1;
            transpose_item(P.in[17], 4096, 1024, W2, 2, nullptr, scr, r, 32, lane);
        }
        f32x4 gp[4];
#pragma unroll
        for (int j = 0; j < 4; ++j) gp[j] = *(const f32x4*)(P.in[2] + 4 * lane + 256 * j);
        for (int m = gw; m < MALL; m += NGW) {
            unsigned long long* o8 = (unsigned long long*)(U + (size_t)m * 1024) + lane;
            if (m >= MX + N_META) {
#pragma unroll
                for (int j = 0; j < 4; ++j) o8[64 * j] = 0ull;
                continue; }
            const float* src = (m < MX) ? XIN + (size_t)m * 1024 : P.in[1] + (size_t)(m - MX) * 1024;
            f32x4 v[4]; float s = 0.f;
#pragma unroll
            for (int j = 0; j < 4; ++j) { v[j] = *(const f32x4*)(src + 4 * lane + 256 * j); s += (v[j][0] * v[j][0] + v[j][1] * v[j][1]) + (v[j][2] * v[j][2] + v[j][3] * v[j][3]); }
            const float rs = rsqrtf(wave_sum(s) * (1.0f / 1024.0f) + EPS);
#pragma unroll
            for (int j = 0; j < 4; ++j) { const f32x4 y = v[j] * rs * gp[j];
                o8[64 * j] = (unsigned long long)pg8::cvt_pk_bf16(y[0], y[1]) | ((unsigned long long)pg8::cvt_pk_bf16(y[2], y[3]) << 32); }
        }
        const int gt = vcu * 512 + tid, NGT = G * 512;
        for (int i = gt; i < 4 * MALL; i += NGT) RQ[i] = 0.f;
        for (int i = gt; i < LTOT * 32; i += NGT) {
            const int pos = i >> 5, fi = i & 31;
            const float ang = (float)pos * P.inv_freq[fi];
            const double a = (double)ang; const double k = rint(a * 0.6366197723675814); const double r = fma(-k, 1.5707963267948966, a) - k * 6.123233995736766e-17;
            const double r2 = r * r;
            double sn = r * (1.0 + r2 * (-1.0 / 6 + r2 * (1.0 / 120 + r2 * (-1.0 / 5040 + r2 * (1.0 / 362880 + r2 * (-1.0 / 39916800 + r2 * (1.0 / 6227020800.0)))))));
            double cs = 1.0 + r2 * (-0.5 + r2 * (1.0 / 24 + r2 * (-1.0 / 720 + r2 * (1.0 / 40320 + r2 * (-1.0 / 3628800 + r2 * (1.0 / 479001600.0))))));
            const int qd = ((int)k) & 3;
            double c_, s_;
            if (qd == 0) { c_ = cs; s_ = sn; } else if (qd == 1) { c_ = -sn; s_ = cs; } else if (qd == 2) { c_ = -cs; s_ = -sn; } else { c_ = sn; s_ = -cs; }
            TAB[2 * i] = (float)c_; TAB[2 * i + 1] = (float)s_;
        }
    }
#endif
    if (P.ws == nullptr) grid.sync();
    xcd_barrier(xbar);
    if (tid == 0) { unsigned base = 0, n[8];
#pragma unroll
        for (int j = 0; j < 8; ++j) n[j] = __hip_atomic_load(ctl + 16 * j, __ATOMIC_RELAXED, __HIP_MEMORY_SCOPE_AGENT);
#pragma unroll
        for (int j = 0; j < 8; ++j) if ((unsigned)j < xcc) base += n[j];
        misc[1] = base + misc[0]; }
    __syncthreads();
    if (G == 256) { vcu = __builtin_amdgcn_readfirstlane((int)misc[1]); cid = (vcu & 31) * 8 + (vcu >> 5); gw = vcu * 8 + wave; }

#if (PH >> 1) & 1
    {
        pg8::Gemm g{U, WIN, MALL, NPROJ, 1024, 1024}; pg8::StaticOrder S; S.init(MALL, NPROJ, G, cid);
        pg8::EpiIn E{PROJ, KD, VD, KR, RQ, RKV, TAB, ctl + 128};
        pg8::gemm_phase<pg8::EpiIn, pg8::StaticOrder, true, true>(lds, g, S, E);
    }
#endif
    xcd_barrier(xbar);

#if (PH >> 2) & 1
    {
        pg8::Gemm g{PROJ + 512, WQ, MX, 768, 256, PPITCH}; pg8::StaticOrder S; S.init(MX, 768, G, cid);
        pg8::EpiQ E{QM, RQ, TAB};
        pg8::gemm_phase<pg8::EpiQ, pg8::StaticOrder, true, true>(lds, g, S, E);
    }
    {
        pg8::Gemm g{PROJ + 768, WKV, MALL, 1024, 128, PPITCH}; pg8::StaticOrder S; S.init(MALL, 1024, G, (cid + 128) % G);
        pg8::EpiKV E{KN, VM, RKV};
        pg8::gemm_phase<pg8::EpiKV, pg8::StaticOrder, true, true>(lds, g, S, E);
    }
#endif
    xcd_barrier(xbar);

#if (PH >> 3) & 1
    {
        float a = P.in[4][lane] * P.in[5][lane], c = P.in[6][lane] * P.in[7][lane];
        a = wave_sum(a); c = wave_sum(c);
        const float lam = expf(a) - expf(c) + 0.2f;
        const att::Tensors T{PROJ, KD, VD, QM, KN, VM, KR, MIX, P.in[8], ctl + 128};
        if (G == 256) {
            const int b = vcu >> 5, i = vcu & 31;
            for (int j = 0; j < 6; ++j) {
                if (j == 2) att::attn_unit<false>(lds, T, b, i < 16 ? 0 : 1, i & 15, 0.f);
                else if (j == 5) att::attn_unit<false>(lds, T, b, i < 16 ? 2 : 3, 15 - (i & 15), 0.f);
                else { const int hh = j < 2 ? j : j - 1; att::attn_unit<true>(lds, T, b, hh, (hh == 0 || hh == 3) ? i : 31 - i, lam); }
            }
        }
    }
#endif
    xcd_barrier(xbar);

#if (PH >> 4) & 1
    {
        pg8::Gemm g{MIX, WO, MX, 1024, 1024, 1024}; pg8::StaticOrder S; S.init(MX, 1024, G, cid);
        pg8::EpiSS E{MIXO, 1024, SS1};
        pg8::gemm_phase<pg8::EpiSS, pg8::StaticOrder, true, true>(lds, g, S, E);
    }
#endif
    xcd_barrier(xbar);

#if (PH >> 5) & 1
    {
        f32x4 g1[4], g2[4];
#pragma unroll
        for (int j = 0; j < 4; ++j) { g1[j] = *(const f32x4*)(P.in[14] + 4 * lane + 256 * j); g2[j] = *(const f32x4*)(P.in[15] + 4 * lane + 256 * j); }
        for (int m = gw; m < MX; m += NGW) {
            const float r1 = rsqrtf(SS1[m] * (1.0f / 1024.0f) + EPS);
            const unsigned long long* mi = (const unsigned long long*)(MIXO + (size_t)m * 1024) + lane;
            f32x4 hv[4]; float s = 0.f;
#pragma unroll
            for (int j = 0; j < 4; ++j) { const f32x4 xv = *(const f32x4*)(XIN + (size_t)m * 1024 + 4 * lane + 256 * j); const unsigned long long w = mi[64 * j];
                f32x4 mv; mv[0] = __uint_as_float((unsigned)(w & 0xffffu) << 16); mv[1] = __uint_as_float((unsigned)w & 0xffff0000u); mv[2] = __uint_as_float((unsigned)((w >> 32) & 0xffffu) << 16); mv[3] = __uint_as_float((unsigned)(w >> 32) & 0xffff0000u);
                hv[j] = xv + mv * r1 * g1[j]; s += (hv[j][0] * hv[j][0] + hv[j][1] * hv[j][1]) + (hv[j][2] * hv[j][2] + hv[j][3] * hv[j][3]);
                ((unsigned long long*)(MIXO + (size_t)m * 1024) + lane)[64 * j] = (unsigned long long)pg8::cvt_pk_bf16(hv[j][0], hv[j][1]) | ((unsigned long long)pg8::cvt_pk_bf16(hv[j][2], hv[j][3]) << 32); }
            const float rs = rsqrtf(wave_sum(s) * (1.0f / 1024.0f) + EPS);
            unsigned long long* o8 = (unsigned long long*)(U + (size_t)m * 1024) + lane;
#pragma unroll
            for (int j = 0; j < 4; ++j) { const f32x4 y = hv[j] * rs * g2[j];
                o8[64 * j] = (unsigned long long)pg8::cvt_pk_bf16(y[0], y[1]) | ((unsigned long long)pg8::cvt_pk_bf16(y[2], y[3]) << 32); }
        }
    }
#endif
    xcd_barrier(xbar);

#if (PH >> 6) & 1
    {
        pg8::Gemm g{U, W1, MX, D_FF, 1024, 1024}; pg8::StaticOrder S; S.init(MX, D_FF, G, cid);
        pg8::EpiRelu2 E{HB, D_FF};
        pg8::gemm_phase<pg8::EpiRelu2, pg8::StaticOrder, true, true>(lds, g, S, E);
    }
#endif
    xcd_barrier(xbar);

#if (PH >> 7) & 1
    {
        pg8::Gemm g{HB, W2, MX, 1024, D_FF, D_FF}; pg8::StaticOrder S; S.init(MX, 1024, G, cid);
        pg8::EpiSS E{FB, 1024, SS2};
        pg8::gemm_phase<pg8::EpiSS, pg8::StaticOrder, true, true>(lds, g, S, E);
    }
#endif
    xcd_barrier(xbar);

#if (PH >> 8) & 1
    {
        f32x4 g3[4];
#pragma unroll
        for (int j = 0; j < 4; ++j) g3[j] = *(const f32x4*)(P.in[18] + 4 * lane + 256 * j);
        for (int m = gw; m < MX; m += NGW) {
            const float r2 = rsqrtf(SS2[m] * (1.0f / 1024.0f) + EPS);
            const unsigned long long* fi = (const unsigned long long*)(FB + (size_t)m * 1024) + lane;
#pragma unroll
            for (int j = 0; j < 4; ++j) { float* op = P.out + (size_t)m * 1024 + 4 * lane + 256 * j; const unsigned long long hw = ((const unsigned long long*)(MIXO + (size_t)m * 1024) + lane)[64 * j];
                f32x4 hv; hv[0] = __uint_as_float((unsigned)(hw & 0xffffu) << 16); hv[1] = __uint_as_float((unsigned)hw & 0xffff0000u); hv[2] = __uint_as_float((unsigned)((hw >> 32) & 0xffffu) << 16); hv[3] = __uint_as_float((unsigned)(hw >> 32) & 0xffff0000u);
                const unsigned long long w = fi[64 * j];
                f32x4 mv; mv[0] = __uint_as_float((unsigned)(w & 0xffffu) << 16); mv[1] = __uint_as_float((unsigned)w & 0xffff0000u); mv[2] = __uint_as_float((unsigned)((w >> 32) & 0xffffu) << 16); mv[3] = __uint_as_float((unsigned)(w >> 32) & 0xffff0000u);
                *(f32x4*)op = hv + mv * r2 * g3[j]; }
        }
    }
#endif
}

extern "C" void kernel_launch(void* const* d_in, const int* in_sizes, int n_in, void* d_out, int out_size, void* d_ws, size_t ws_size, hipStream_t stream) {
    static int grid = 0;
    if (grid == 0) {
        if (n_in != 19 || in_sizes[0] != MX * D_MODEL || out_size != MX * D_MODEL || ws_size < WS_END) {
            fprintf(stderr, "kernel_launch: unexpected shapes (n_in %d, in0 %d, out %d, ws %zu); nothing launched\n", n_in, n_in > 0 ? in_sizes[0] : -1, out_size, ws_size); grid = -1; return; }
        int dev = 0, cus = 0, per_cu = 0;
        hipGetDevice(&dev);
        hipDeviceGetAttribute(&cus, hipDeviceAttributeMultiprocessorCount, dev);
        if (hipFuncSetAttribute((const void*)fwd_megakernel, hipFuncAttributeMaxDynamicSharedMemorySize, LDS_BYTES) != hipSuccess) { fprintf(stderr, "kernel_launch: hipFuncSetAttribute failed\n"); grid = -1; return; }
        if (hipOccupancyMaxActiveBlocksPerMultiprocessor(&per_cu, (const void*)fwd_megakernel, 512, LDS_BYTES) != hipSuccess || per_cu < 1) { fprintf(stderr, "kernel_launch: occupancy query failed (%d)\n", per_cu); grid = -1; return; }
        grid = cus;
        fprintf(stderr, "kernel_launch: cus %d per_cu %d grid %d\n", cus, per_cu, grid);
    }
    if (grid < 0) return;
    Params p{};
    for (int i = 0; i < 19; ++i) p.in[i] = (const float*)d_in[i];
    p.out = (float*)d_out; p.ws = (unsigned char*)d_ws;
    for (int i = 0; i < 32; ++i) p.inv_freq[i] = 1.0f / powf(10000.0f, (float)(2 * i) / 64.0f);
    if (hipMemsetAsync((char*)d_ws + WS_CTL, 0, 32768, stream) != hipSuccess) { fprintf(stderr, "kernel_launch: memset failed\n"); return; }
    void* args[] = {&p};
    hipError_t e = hipLaunchCooperativeKernel((const void*)fwd_megakernel, dim3(grid), dim3(512), args, LDS_BYTES, stream);
    if (e != hipSuccess) fprintf(stderr, "cooperative launch failed: %s (grid %d)\n", hipGetErrorString(e), grid);
}
```
